# Optimizing an MI355X kernel written in HIP

```python
import jax, jax.numpy as jnp
from jax import lax
import numpy as np

D_MODEL = 4096
BATCH = 8
SEQ = 2048
DEPTH = 4

N_A_LAYERS = DEPTH // 2
N_B_LAYERS = DEPTH - N_A_LAYERS
POOL_WINDOWS = (2, 4, 8, 16)
N_POOL_GROUPS = len(POOL_WINDOWS)
POOL_GROUP_DIM = D_MODEL // N_POOL_GROUPS
HEAD_DIM = 128
N_HEADS = D_MODEL // HEAD_DIM
Q_BLOCK = 128
D_FF = ((8 * D_MODEL // 3 + 255) // 256) * 256
CONV_WIDTH = 3
EPS = 1e-6

kernel_name = "yoco_pool_forgetting_attention_convffn"


def rms_norm(x, g):
    x32 = x.astype(jnp.float32)
    y = x32 * lax.rsqrt(jnp.mean(x32 * x32, axis=-1, keepdims=True) + EPS)
    return (y * g.astype(jnp.float32)).astype(x.dtype)


def causal_window_mean(u, w):
    S = u.shape[1]
    c = jnp.cumsum(u.astype(jnp.float32), axis=1)
    c = jnp.pad(c, ((0, 0), (1, 0), (0, 0)))
    lag = jnp.pad(c, ((0, 0), (w - 1, 0), (0, 0)))[:, :S]
    count = jnp.minimum(jnp.arange(S) + 1, w).astype(jnp.float32)[None, :, None]
    return (c[:, 1:] - lag) / count


def pool_mixer(h, w_pool, scale):
    B, S, D = h.shape
    hg = h.reshape(B, S, N_POOL_GROUPS, POOL_GROUP_DIM)
    pooled = jnp.stack(
        [causal_window_mean(hg[:, :, g], w) for g, w in enumerate(POOL_WINDOWS)], axis=2)
    mix = (pooled - hg.astype(jnp.float32)).astype(h.dtype)
    y = jnp.einsum('bsgc,gcd->bsgd', mix, w_pool).reshape(B, S, D)
    return y * scale


def conv_ffn(h, w_up, conv_w, conv_b, w_down):
    S = h.shape[1]
    u = h @ w_up
    up = jnp.pad(u, ((0, 0), (CONV_WIDTH - 1, 0), (0, 0)))
    y = conv_b
    for k in range(CONV_WIDTH):
        start = CONV_WIDTH - 1 - k
        y = y + conv_w[k] * up[:, start:start + S]
    gate, val = jnp.split(y, 2, axis=-1)
    return (jax.nn.silu(gate) * val) @ w_down


def shared_kv(h_kv, w_kvf, b_f):
    B, S, _ = h_kv.shape
    kvf = h_kv @ w_kvf
    k, v, f_logit = jnp.split(kvf, [D_MODEL, 2 * D_MODEL], axis=-1)
    k = k.reshape(B, S, N_HEADS, HEAD_DIM).transpose(0, 2, 1, 3)
    v = v.reshape(B, S, N_HEADS, HEAD_DIM).transpose(0, 2, 1, 3)
    log_f = jax.nn.log_sigmoid((f_logit + b_f).astype(jnp.float32))
    cum = jnp.cumsum(log_f, axis=1).transpose(0, 2, 1)
    return k, v, cum


def forgetting_attention(h, w_q, w_o, k, v, cum):
    B, S, _ = h.shape
    n_blocks = S // Q_BLOCK
    q = (h @ w_q).reshape(B, S, N_HEADS, HEAD_DIM).transpose(0, 2, 1, 3)
    qb = q.reshape(B, N_HEADS, n_blocks, Q_BLOCK, HEAD_DIM).transpose(2, 0, 1, 3, 4)
    cb = cum.reshape(B, N_HEADS, n_blocks, Q_BLOCK).transpose(2, 0, 1, 3)
    key_pos = jnp.arange(S)
    scale = HEAD_DIM ** -0.5
    neg = jnp.finfo(jnp.float32).min

    def block(args):
        i, q_i, c_i = args
        logits = jnp.einsum('bhqd,bhkd->bhqk', q_i, k).astype(jnp.float32) * scale
        logits = logits + c_i[..., :, None] - cum[..., None, :]
        q_pos = i * Q_BLOCK + jnp.arange(Q_BLOCK)
        causal = key_pos[None, :] <= q_pos[:, None]
        logits = jnp.where(causal, logits, neg)
        p = jax.nn.softmax(logits, axis=-1).astype(v.dtype)
        return jnp.einsum('bhqk,bhkd->bhqd', p, v)

    o = lax.map(block, (jnp.arange(n_blocks), qb, cb))
    o = o.transpose(1, 0, 3, 2, 4).reshape(B, S, D_MODEL)
    return o @ w_o


def setup_inputs(seed: int = 0) -> dict:
    key = jax.random.key(seed)
    ks = jax.random.split(key, 20)
    f32 = jnp.float32
    D, F, H = D_MODEL, D_FF, N_HEADS

    def nrm(k, shape, s):
        return jax.random.normal(k, shape, f32) * s

    return {
        "x": nrm(ks[0], (BATCH, SEQ, D), 1.0),
        "ln_mix": 1.0 + nrm(ks[1], (DEPTH, D), 0.02),
        "ln_ffn": 1.0 + nrm(ks[2], (DEPTH, D), 0.02),
        "pool_w": nrm(ks[3], (N_A_LAYERS, N_POOL_GROUPS, POOL_GROUP_DIM, POOL_GROUP_DIM), POOL_GROUP_DIM ** -0.5),
        "pool_scale": 0.5 + nrm(ks[4], (N_A_LAYERS, D), 0.1),
        "kv_norm": 1.0 + nrm(ks[5], (D,), 0.02),
        "w_kvf": nrm(ks[6], (D, 2 * D + H), D ** -0.5),
        "b_f": jax.random.uniform(ks[7], (H,), f32, 1.0, 5.0),
        "w_q": nrm(ks[8], (N_B_LAYERS, D, D), D ** -0.5),
        "w_o": nrm(ks[9], (N_B_LAYERS, D, D), D ** -0.5),
        "w_up": nrm(ks[10], (DEPTH, D, 2 * F), D ** -0.5),
        "conv_w": nrm(ks[11], (DEPTH, CONV_WIDTH, 2 * F), CONV_WIDTH ** -0.5),
        "conv_b": nrm(ks[12], (DEPTH, 2 * F), 0.01),
        "w_down": nrm(ks[13], (DEPTH, F, D), F ** -0.5),
        "final_norm": 1.0 + nrm(ks[14], (D,), 0.02),
    }


def reference(x, ln_mix, ln_ffn, pool_w, pool_scale, kv_norm, w_kvf, b_f,
              w_q, w_o, w_up, conv_w, conv_b, w_down, final_norm):
    h = x
    for layer in range(N_A_LAYERS):
        h = h + pool_mixer(rms_norm(h, ln_mix[layer]), pool_w[layer], pool_scale[layer])
        h = h + conv_ffn(rms_norm(h, ln_ffn[layer]), w_up[layer], conv_w[layer],
                         conv_b[layer], w_down[layer])
    k, v, cum = shared_kv(rms_norm(h, kv_norm), w_kvf, b_f)
    for j in range(N_B_LAYERS):
        layer = N_A_LAYERS + j
        h = h + forgetting_attention(rms_norm(h, ln_mix[layer]), w_q[j], w_o[j], k, v, cum)
        h = h + conv_ffn(rms_norm(h, ln_ffn[layer]), w_up[layer], conv_w[layer],
                         conv_b[layer], w_down[layer])
    return rms_norm(h, final_norm)
```

```cpp
#include <hip/hip_runtime.h>
#include <cstdio>
#include <cstdint>

#define LAS __attribute__((address_space(3)))
typedef unsigned short bf16_t;
typedef short bf16x8 __attribute__((ext_vector_type(8)));
typedef short s16x4 __attribute__((ext_vector_type(4)));
typedef float f32x4 __attribute__((ext_vector_type(4)));
typedef float f32x16 __attribute__((ext_vector_type(16)));
typedef unsigned u32x4 __attribute__((ext_vector_type(4)));

constexpr int DM = 4096, NB = 8, SEQ = 2048, MTOK = NB * SEQ, FF = 11008, FF2 = 2 * FF, NH = 32, HD = 128;
constexpr int NKVF = 2 * DM + NH, NKVFP = 8448;
constexpr float EPS = 1e-6f;
constexpr float ATT_SCALE = 0.08838834764831845f;
constexpr int NTHREADS = 512, NWAVES = 8;

constexpr size_t al256(size_t x) { return (x + 255) & ~(size_t)255; }
constexpr size_t WS_CTL = 0, CTL_BYTES = 1u << 20;
constexpr size_t SZ_WUP = (size_t)FF2 * DM * 2, SZ_WDN = (size_t)DM * FF * 2, SZ_WSQ = (size_t)DM * DM * 2, SZ_WKVF = (size_t)NKVFP * DM * 2, SZ_WP = (size_t)DM * 1024 * 2;
constexpr size_t WS_WUP = WS_CTL + CTL_BYTES;
constexpr size_t WS_WDN = WS_WUP + 4 * SZ_WUP;
constexpr size_t WS_WQ = WS_WDN + 4 * SZ_WDN;
constexpr size_t WS_WO = WS_WQ + 2 * SZ_WSQ;
constexpr size_t WS_WKVF = WS_WO + 2 * SZ_WSQ;
constexpr size_t WS_WP = WS_WKVF + SZ_WKVF;
constexpr size_t SZ_ACT = (size_t)MTOK * DM * 2;
constexpr size_t WS_HB = WS_WP + 2 * SZ_WP;
constexpr size_t WS_X1 = WS_HB + SZ_ACT;
constexpr size_t WS_X2 = WS_X1 + SZ_ACT;
constexpr size_t WS_KB = WS_X2 + SZ_ACT;
constexpr size_t WS_VB = WS_KB + SZ_ACT;
constexpr size_t WS_FLOG = WS_VB + SZ_ACT;
constexpr size_t WS_G = WS_FLOG + SZ_ACT;
constexpr size_t WS_UH = WS_G + (size_t)MTOK * FF * 2;
constexpr size_t WS_SLOTS = WS_UH + (size_t)128 * 4 * FF2 * 4;
constexpr size_t WS_CBIAS = WS_SLOTS + (size_t)MTOK * 64 * 4;
constexpr size_t WS_RSTD = WS_CBIAS + (size_t)NB * NH * SEQ * 4;
constexpr size_t WS_END0 = WS_RSTD + (size_t)MTOK * 4;
constexpr size_t WS_DUM_H = WS_END0, WS_DUM_HB = WS_DUM_H + 2 * SZ_ACT, WS_DUM_SLOTS = WS_DUM_HB + SZ_ACT;
constexpr size_t WS_END = WS_DUM_SLOTS + (size_t)MTOK * 64 * 4;

constexpr int RING_BYTES = 131072;
constexpr int LDSCTL_OFF = 139264;
constexpr int LDS_BYTES = 147456;

__device__ __forceinline__ unsigned cvt_pk_bf16(float lo, float hi) { unsigned r; asm volatile("v_cvt_pk_bf16_f32 %0, %1, %2" : "=v"(r) : "v"(lo), "v"(hi)); return r; }
__device__ __forceinline__ u32x4 pack8u(f32x4 a, f32x4 b) { u32x4 w; w.x = cvt_pk_bf16(a[0], a[1]); w.y = cvt_pk_bf16(a[2], a[3]); w.z = cvt_pk_bf16(b[0], b[1]); w.w = cvt_pk_bf16(b[2], b[3]); return w; }
__device__ __forceinline__ float wave_sum(float v) {
#pragma unroll
    for (int o = 1; o < 64; o <<= 1) v += __shfl_xor(v, o);
    return v;
}
__device__ __forceinline__ float silu_f(float y) { return y * __builtin_amdgcn_rcpf(1.0f + __builtin_amdgcn_exp2f(-1.4426950408889634f * y)); }

#define XB_TMO      128
#define XB_XCNT(j)  (256  + 64 * (j))
#define XB_XSUB(j)  (1280 + 64 * (j))
#define XB_XGEN(j)  (2304 + 64 * (j))
#define XB_TOP      3328
#define XB_TOPGEN   3392
#define XCD_BAR_WORDS 3456
#define XB_SPIN_CAP (1u << 22)

__device__ __forceinline__ unsigned xb_ld(unsigned* p)              { return __hip_atomic_load(p, __ATOMIC_RELAXED, __HIP_MEMORY_SCOPE_AGENT); }
__device__ __forceinline__ unsigned xb_add(unsigned* p, unsigned v) { return __hip_atomic_fetch_add(p, v, __ATOMIC_RELAXED, __HIP_MEMORY_SCOPE_AGENT); }
__device__ __forceinline__ unsigned xb_xcc_id() { return (unsigned)__builtin_amdgcn_s_getreg((3 << 11) | 20) & 0xFu; }
#define XB_SPIN(cond, bar) do { unsigned _sp = 0; while (cond) { __builtin_amdgcn_s_sleep(1); \
    if ((++_sp & 255u) == 0u) { if (xb_ld(&(bar)[XB_TMO])) break; if (_sp > XB_SPIN_CAP) { atomicAdd(&(bar)[XB_TMO], 1u); break; } } } } while (0)

struct XcdBarrier { unsigned* bar; unsigned x; volatile LAS unsigned* st; };
__device__ __forceinline__ XcdBarrier xcd_barrier_post(unsigned* bar, volatile LAS unsigned* st) {
    XcdBarrier b; b.bar = bar; b.x = xb_xcc_id(); b.st = st;
    if (threadIdx.x == 0) (void)xb_add(&bar[XB_XCNT(b.x)], 1u);
    return b;
}
__device__ __forceinline__ void xcd_barrier_complete(unsigned* bar, unsigned x, unsigned& nloc, unsigned& nx) {
    const unsigned G = gridDim.x * gridDim.y * gridDim.z;
    unsigned sum, cnt, mine, sp = 0u;
    for (;;) {
        sum = 0u; cnt = 0u; mine = 0u;
#pragma unroll
        for (unsigned j = 0; j < 16; ++j) { const unsigned c = xb_ld(&bar[XB_XCNT(j)]); sum += c; cnt += (c > 0u) ? 1u : 0u; mine = (j == x) ? c : mine; }
        if (sum == G) break;
        __builtin_amdgcn_s_sleep(1);
        if ((++sp & 255u) == 0u) { if (xb_ld(&bar[XB_TMO])) break; if (sp > XB_SPIN_CAP) { atomicAdd(&bar[XB_TMO], 1u); break; } }
    }
    nloc = mine > 0u ? mine : 1u; nx = cnt > 0u ? cnt : 1u;
}
__device__ __forceinline__ void xcd_barrier(const XcdBarrier& b) {
    asm volatile("s_waitcnt vmcnt(0)" ::: "memory");
    __syncthreads();
    if (threadIdx.x == 0) {
        unsigned* bar = b.bar;
        __builtin_amdgcn_s_waitcnt(0);
        unsigned nloc = b.st[0], nx = b.st[1];
        if (nloc == 0u) { xcd_barrier_complete(bar, b.x, nloc, nx); b.st[0] = nloc; b.st[1] = nx; }
        const unsigned old = xb_add(&bar[XB_XSUB(b.x)], 1u);
        const unsigned gen = old / nloc;
        if (old + 1u == (gen + 1u) * nloc) {
            __builtin_amdgcn_fence(__ATOMIC_RELEASE, "agent");
            asm volatile("s_waitcnt vmcnt(0)" ::: "memory");
            const unsigned og = xb_add(&bar[XB_TOP], 1u);
            const unsigned tg = og / nx;
            if (og + 1u == (tg + 1u) * nx) xb_add(&bar[XB_TOPGEN], 1u);
            else XB_SPIN(xb_ld(&bar[XB_TOPGEN]) == tg, bar);
            __builtin_amdgcn_fence(__ATOMIC_ACQUIRE, "agent");
            xb_add(&bar[XB_XGEN(b.x)], 1u);
            asm volatile("s_waitcnt vmcnt(0)" ::: "memory");
        } else {
            XB_SPIN(xb_ld(&bar[XB_XGEN(b.x)]) == gen, bar);
            __builtin_amdgcn_fence(__ATOMIC_ACQUIRE, "agent");
            asm volatile("s_waitcnt vmcnt(0)" ::: "memory");
        }
    }
    __syncthreads();
}

namespace pg8 {
constexpr int BM = 256, BK = 64, HALF = 128, HTB = HALF * BK * 2, STAGE_BYTES = 8 * HTB, NXCD = 8, WGM = 4;
__host__ __device__ __forceinline__ int lds_byte(int r, int c) { const int st = (r >> 4) * 2 + (c >> 5), rr = r & 15, cc = c & 31, ob = rr * 64 + cc * 2; return st * 1024 + (ob ^ (((ob >> 9) & 1) << 5)); }
__host__ __device__ __forceinline__ void stage_rc(int b, int& R, int& C) { const int st = b / 1024, sb = b % 1024, swz = sb ^ (((sb >> 9) & 1) << 5); R = (st >> 1) * 16 + swz / 64; C = (st & 1) * 32 + (swz % 64) / 2; }
__host__ __device__ __forceinline__ int perm32(int rho) { const int n = rho >> 4, i = rho & 15; return 8 * (i >> 2) + 4 * n + (i & 3); }

struct Unit { int pm, pn; };
struct Gemm { const bf16_t* A; const bf16_t* Bt; int M, N, K, lda, grouped; int fake = 0; int atile = 0; };

struct StaticOrder {
    int nM, nN, nwg, G, c, wgm;
    __host__ __device__ void init(int M, int N, int G_, int c_, int wgm_ = WGM) { nM = M / BM; nN = N / BM; nwg = nM * nN; G = G_; c = c_; wgm = wgm_; }
    __host__ __device__ bool next(int i, Unit& u) const {
        const long L = (long)i * G + c; if (L >= nwg) return false;
        int wgid = (int)L; { const int q = nwg / NXCD, r = nwg % NXCD, xcd = wgid % NXCD, off = wgid / NXCD; wgid = (xcd < r ? xcd * (q + 1) : r * (q + 1) + (xcd - r) * q) + off; }
        const int nig = wgm * nN, gid = wgid / nig, fm = gid * wgm, gsz = (nM - fm) < wgm ? (nM - fm) : wgm;
        u.pm = fm + ((wgid % nig) % gsz); u.pn = (wgid % nig) / gsz; return true;
    }
};

template <class Epi, bool PERMA, bool MF32 = false>
__device__ __forceinline__ void gemm_phase(LAS unsigned char* lds, const Gemm g, const StaticOrder& S, const Epi& E) {
    int tid = threadIdx.x; asm volatile("" : "+v"(tid));
    const int wid = __builtin_amdgcn_readfirstlane(tid >> 6), lane = tid & 63, wr = wid >> 2, wc = wid & 3, fr = lane & 15, fq = lane >> 4;
    const int K = g.K, nt = K / BK, lda = g.lda;
    unsigned voffA[2], voffB[2];
#pragma unroll
    for (int i = 0; i < 2; ++i) { int R, C; stage_rc(tid * 16 + i * 8192, R, C);
        const int Rb = (R & ~31) + perm32(R & 31);
        const int Ra = PERMA ? (128 * (R >> 6) + 8 * (R & 15) + ((R >> 4) & 3)) : R;
        voffA[i] = g.atile ? (unsigned)(Ra * 64 + C) * 2u : (unsigned)(Ra * lda + C) * 2u; voffB[i] = (unsigned)(Rb * 64 + C) * 2u; }
    const size_t kstep = (size_t)(BK * 2);
    const size_t hstepA = PERMA ? (size_t)4 * lda * 2 : (g.atile ? (size_t)HALF * 64 * 2 : (size_t)HALF * lda * 2);
    const size_t kstepA = g.atile ? (size_t)BM * 64 * 2 : kstep;
    const size_t hstepB = (size_t)HALF * 64 * 2, kstepB = (size_t)BM * 64 * 2;
    const size_t tstepA = (size_t)BM * lda * 2, tstepB = (size_t)BM * K * 2;
    const unsigned ldsw = (unsigned)wid * 1024u;
    const int aoff = lds_byte(wr * 64 + fr, fq * 8), boff = lds_byte(wc * 32 + fr, fq * 8);
#define PG8_SA(b, h) (((b) * 2 + (h)) * HTB)
#define PG8_SB(b, h) ((4 + (b) * 2 + (h)) * HTB)
#define PG8_STAGE(bufoff, gbase, voff) do { _Pragma("unroll") for (int _i = 0; _i < 2; ++_i) \
        __builtin_amdgcn_global_load_lds((const unsigned*)((const char*)(gbase) + (voff)[_i]), (LAS unsigned*)(lds + (bufoff) + ldsw + _i * 8192), 16, 0, 0); } while (0)
#define PG8_LDA(dst, b, h) do { _Pragma("unroll") for (int m = 0; m < 4; ++m) _Pragma("unroll") for (int k = 0; k < 2; ++k) dst[m][k] = *(const LAS bf16x8*)(lds + PG8_SA(b, h) + aoff + m * 2048 + k * 1024); } while (0)
#define PG8_LDB(dst, b, h) do { _Pragma("unroll") for (int n = 0; n < 2; ++n) _Pragma("unroll") for (int k = 0; k < 2; ++k) dst[n][k] = *(const LAS bf16x8*)(lds + PG8_SB(b, h) + boff + n * 2048 + k * 1024); } while (0)
#define PG8_MMA(ai, bj, At, Bt) do { __builtin_amdgcn_s_setprio(1); if constexpr (MF32) { _Pragma("unroll") for (int blk = 0; blk < 2; ++blk) _Pragma("unroll") for (int kk = 0; kk < 4; ++kk) \
        acc32[ai][bj][blk] = __builtin_amdgcn_mfma_f32_32x32x16_bf16(Bt[kk & 1][kk >> 1], At[2 * blk + (kk & 1)][kk >> 1], acc32[ai][bj][blk], 0, 0, 0); } else { \
        _Pragma("unroll") for (int m = 0; m < 4; ++m) _Pragma("unroll") for (int n = 0; n < 2; ++n) _Pragma("unroll") for (int k = 0; k < 2; ++k) \
        acc[ai][bj][m][n] = __builtin_amdgcn_mfma_f32_16x16x32_bf16(Bt[n][k], At[m][k], acc[ai][bj][m][n], 0, 0, 0); } __builtin_amdgcn_s_setprio(0); } while (0)
#define PG8_WAIT_V(n) asm volatile("s_waitcnt vmcnt(" #n ")" ::: "memory")
#define PG8_WAIT_L(n) asm volatile("s_waitcnt lgkmcnt(" #n ")" ::: "memory")
#define PG8_BAR __builtin_amdgcn_s_barrier()
#define PG8_SCHED __builtin_amdgcn_sched_barrier(0)
    Unit cur, nxt; int ui = 0;
    if (!S.next(0, cur)) return;
    f32x4 acc[2][2][4][2];
#pragma unroll
    for (int a = 0; a < 2; ++a)
#pragma unroll
        for (int b = 0; b < 2; ++b)
#pragma unroll
            for (int m = 0; m < 4; ++m)
#pragma unroll
                for (int n = 0; n < 2; ++n) acc[a][b][m][n] = (f32x4){0.f, 0.f, 0.f, 0.f};
    f32x16 acc32[2][2][2] = {};
    bf16x8 At[4][2], B0[2][2], B1[2][2];
#define PG8_ABASE(u) ((const char*)g.A + (size_t)((g.fake & 1) ? 0 : (u).pm) * tstepA + (g.grouped ? (size_t)((u).pn >> 2) * K * 2 : (size_t)0))
#define PG8_BBASE(u) ((const char*)g.Bt + (size_t)((g.fake & 2) ? 0 : (u).pn) * tstepB)
    const char* cA = PG8_ABASE(cur); const char* cB = PG8_BBASE(cur);
    PG8_STAGE(PG8_SB(0, 0), cB, voffB); PG8_STAGE(PG8_SA(0, 0), cA, voffA); PG8_STAGE(PG8_SB(0, 1), cB + hstepB, voffB); PG8_STAGE(PG8_SA(0, 1), cA + hstepA, voffA);
    if (wr == 1) PG8_BAR;
    PG8_WAIT_V(4); PG8_BAR;
    PG8_STAGE(PG8_SB(1, 0), cB + kstepB, voffB); PG8_STAGE(PG8_SA(1, 0), cA + kstepA, voffA); PG8_STAGE(PG8_SB(1, 1), cB + hstepB + kstepB, voffB);
    PG8_WAIT_V(6); PG8_BAR;
    for (;;) {
        const bool has_next = S.next(ui + 1, nxt);
        const char* nA = has_next ? PG8_ABASE(nxt) : cA; const char* nB = has_next ? PG8_BBASE(nxt) : cB;
        for (int t = 0; t < nt; t += 2) {
            const bool last = (t == nt - 2);
            const char* a1 = cA + (size_t)(t + 1) * kstepA;
            const char* a2 = last ? nA : cA + (size_t)(t + 2) * kstepA; const char* b2 = last ? nB : cB + (size_t)(t + 2) * kstepB;
            const char* a3 = a2 + kstepA; const char* b3 = b2 + kstepB;
            PG8_LDB(B0, 0, 0); PG8_SCHED; PG8_LDA(At, 0, 0); PG8_STAGE(PG8_SA(1, 1), a1 + hstepA, voffA);
            PG8_WAIT_L(8); PG8_BAR; PG8_WAIT_L(0); PG8_MMA(0, 0, At, B0); PG8_BAR; PG8_SCHED;
            PG8_LDB(B1, 0, 1); PG8_STAGE(PG8_SB(0, 0), b2, voffB);
            PG8_BAR; PG8_WAIT_L(0); PG8_MMA(0, 1, At, B1); PG8_BAR;
            PG8_LDA(At, 0, 1); PG8_STAGE(PG8_SA(0, 0), a2, voffA);
            PG8_BAR; PG8_WAIT_L(0); PG8_MMA(1, 0, At, B0); PG8_BAR; PG8_SCHED;
            PG8_STAGE(PG8_SB(0, 1), b2 + hstepB, voffB);
            PG8_WAIT_V(6); PG8_BAR; PG8_MMA(1, 1, At, B1); PG8_BAR;
            PG8_LDB(B0, 1, 0); PG8_SCHED; PG8_LDA(At, 1, 0); PG8_STAGE(PG8_SA(0, 1), a2 + hstepA, voffA);
            PG8_WAIT_L(8); PG8_BAR; PG8_WAIT_L(0); PG8_MMA(0, 0, At, B0); PG8_BAR; PG8_SCHED;
            PG8_LDB(B1, 1, 1); PG8_STAGE(PG8_SB(1, 0), b3, voffB);
            PG8_BAR; PG8_WAIT_L(0); PG8_MMA(0, 1, At, B1); PG8_BAR;
            PG8_LDA(At, 1, 1); PG8_STAGE(PG8_SA(1, 0), a3, voffA);
            PG8_BAR; PG8_WAIT_L(0); PG8_MMA(1, 0, At, B0); PG8_BAR; PG8_SCHED;
            PG8_STAGE(PG8_SB(1, 1), b3 + hstepB, voffB);
            PG8_WAIT_V(6); PG8_BAR; PG8_MMA(1, 1, At, B1); PG8_BAR;
        }
        if constexpr (MF32) { if (!E.skip) { _Pragma("unroll") for (int q = 0; q < 8; ++q) *(f32x16*)((float*)E.hout + (size_t)(cur.pm * 8 + q) * 1024 + lane * 16) = acc32[q >> 2][(q >> 1) & 1][q & 1]; }
            _Pragma("unroll") for (int q = 0; q < 8; ++q) acc32[q >> 2][(q >> 1) & 1][q & 1] = f32x16{}; }
        else E(acc, cur, wr, wc, fr, fq);
        if (!has_next) break;
#pragma unroll
        for (int a = 0; a < 2; ++a)
#pragma unroll
            for (int b = 0; b < 2; ++b)
#pragma unroll
                for (int m = 0; m < 4; ++m)
#pragma unroll
                    for (int n = 0; n < 2; ++n) acc[a][b][m][n] = (f32x4){0.f, 0.f, 0.f, 0.f};
        cur = nxt; cA = nA; cB = nB; ++ui;
    }
    PG8_WAIT_V(0);
    if (wr == 0) PG8_BAR;
    PG8_BAR;
#undef PG8_ABASE
#undef PG8_BBASE
#undef PG8_SA
#undef PG8_SB
#undef PG8_STAGE
#undef PG8_LDA
#undef PG8_LDB
#undef PG8_MMA
#undef PG8_WAIT_V
#undef PG8_WAIT_L
#undef PG8_BAR
#undef PG8_SCHED
}

struct EpiQ {
    bf16_t* O; const float* rstd;
    __device__ __forceinline__ void operator()(const f32x4 (&acc)[2][2][4][2], const Unit& u, int wr, int wc, int fr, int fq) const {
        const int col0 = u.pn * BM + wc * 32 + 8 * fq, row0 = u.pm * BM + wr * 64 + fr;
        float rs[2][4];
#pragma unroll
        for (int ai = 0; ai < 2; ++ai)
#pragma unroll
            for (int m = 0; m < 4; ++m) rs[ai][m] = rstd[row0 + ai * HALF + m * 16];
#pragma unroll
        for (int ai = 0; ai < 2; ++ai)
#pragma unroll
            for (int m = 0; m < 4; ++m) { bf16_t* rowp = O + (size_t)(row0 + ai * HALF + m * 16) * DM + col0;
#pragma unroll
                for (int bj = 0; bj < 2; ++bj) *(u32x4*)(rowp + bj * HALF) = pack8u(acc[ai][bj][m][0] * rs[ai][m], acc[ai][bj][m][1] * rs[ai][m]); }
    }
};
struct EpiKVF {
    bf16_t* KVF; const float* rstd;
    __device__ __forceinline__ void operator()(const f32x4 (&acc)[2][2][4][2], const Unit& u, int wr, int wc, int fr, int fq) const {
        bf16_t* base = KVF + (size_t)(u.pn >> 4) * ((size_t)MTOK * DM) + (u.pn & 15) * BM + wc * 32 + 8 * fq; const int row0 = u.pm * BM + wr * 64 + fr;
        float rs[2][4];
#pragma unroll
        for (int ai = 0; ai < 2; ++ai)
#pragma unroll
            for (int m = 0; m < 4; ++m) rs[ai][m] = rstd[row0 + ai * HALF + m * 16];
#pragma unroll
        for (int ai = 0; ai < 2; ++ai)
#pragma unroll
            for (int m = 0; m < 4; ++m) { bf16_t* rowp = base + (size_t)(row0 + ai * HALF + m * 16) * DM;
#pragma unroll
                for (int bj = 0; bj < 2; ++bj) *(u32x4*)(rowp + bj * HALF) = pack8u(acc[ai][bj][m][0] * rs[ai][m], acc[ai][bj][m][1] * rs[ai][m]); }
    }
};
__device__ __forceinline__ f32x4 bf_lo4(u32x4 w) { f32x4 r; r[0] = __uint_as_float(w.x << 16); r[1] = __uint_as_float(w.x & 0xffff0000u); r[2] = __uint_as_float(w.y << 16); r[3] = __uint_as_float(w.y & 0xffff0000u); return r; }
__device__ __forceinline__ f32x4 bf_hi4(u32x4 w) { f32x4 r; r[0] = __uint_as_float(w.z << 16); r[1] = __uint_as_float(w.z & 0xffff0000u); r[2] = __uint_as_float(w.w << 16); r[3] = __uint_as_float(w.w & 0xffff0000u); return r; }
struct EpiRes {
    const bf16_t* hin; bf16_t* hout; float* slots; int skip = 0;
    __device__ __forceinline__ void operator()(const f32x4 (&acc)[2][2][4][2], const Unit& u, int wr, int wc, int fr, int fq) const {
        if (skip) return;
        const int col0 = u.pn * BM + wc * 32 + 8 * fq, row0 = u.pm * BM + wr * 64 + fr;
        u32x4 hv[2][2][2];
#define ER_LOAD(q, buf) do { _Pragma("unroll") for (int mi = 0; mi < 2; ++mi) { const size_t off = (size_t)(row0 + ((q) >> 1) * HALF + (((q) & 1) * 2 + mi) * 16) * DM + col0; \
            _Pragma("unroll") for (int bj = 0; bj < 2; ++bj) hv[buf][mi][bj] = *(const u32x4*)(hin + off + bj * HALF); } \
            asm volatile("" ::: "memory"); } while (0)
#define ER_PROC(q, buf) do { _Pragma("unroll") for (int mi = 0; mi < 2; ++mi) { const int ai = (q) >> 1, m = ((q) & 1) * 2 + mi, row = row0 + ai * HALF + m * 16; const size_t off = (size_t)row * DM + col0; float ss = 0.f; \
            _Pragma("unroll") for (int bj = 0; bj < 2; ++bj) { const f32x4 o0 = bf_lo4(hv[buf][mi][bj]) + acc[ai][bj][m][0], o1 = bf_hi4(hv[buf][mi][bj]) + acc[ai][bj][m][1]; \
                *(u32x4*)(hout + off + bj * HALF) = pack8u(o0, o1); \
                ss += ((o0[0] * o0[0] + o0[1] * o0[1]) + (o0[2] * o0[2] + o0[3] * o0[3])) + ((o1[0] * o1[0] + o1[1] * o1[1]) + (o1[2] * o1[2] + o1[3] * o1[3])); } \
            ss += __shfl_xor(ss, 16); ss += __shfl_xor(ss, 32); if (fq == 0) slots[(size_t)row * 64 + u.pn * 4 + wc] = ss; } \
            asm volatile("" ::: "memory"); } while (0)
        ER_LOAD(0, 0); ER_LOAD(1, 1); ER_PROC(0, 0); ER_LOAD(2, 0); ER_PROC(1, 1); ER_LOAD(3, 1); ER_PROC(2, 0); ER_PROC(3, 1);
#undef ER_LOAD
#undef ER_PROC
    }
};
struct EpiUp {
    bf16_t* G; float* UH; const float* rstd; const float* cw; const float* cb; int skip = 0;
    __device__ __forceinline__ void operator()(f32x4 (&acc)[2][2][4][2], const Unit& u, int wr, int wc, int fr, int fq) const {
        if (skip) return;
        const int rowbase = u.pm * BM + wr * HALF + fr * 8, ch0 = u.pn * HALF + wc * 32 + 8 * fq, blk = u.pm * 2 + wr;
        const size_t gtile = ((size_t)u.pm * (FF / 64) + (ch0 >> 6)) * 16384 + (ch0 & 63);
        const f32x4 rsa = *(const f32x4*)(rstd + rowbase), rsb = *(const f32x4*)(rstd + rowbase + 4);
#pragma unroll
        for (int rr = 0; rr < 8; ++rr) { const float rs = rr < 4 ? rsa[rr & 3] : rsb[rr & 3];
#pragma unroll
            for (int bj = 0; bj < 2; ++bj)
#pragma unroll
                for (int n = 0; n < 2; ++n) acc[rr >> 2][bj][rr & 3][n] *= rs; }
        unsigned keep[8][2];
#pragma unroll
        for (int n = 0; n < 2; ++n) {
            const int ch = ch0 + 4 * n;
#define UG(rr) acc[(rr) >> 2][0][(rr) & 3][n]
#define UV(rr) acc[(rr) >> 2][1][(rr) & 3][n]
            f32x4 pg1, pg2, pv1, pv2;
#pragma unroll
            for (int j = 0; j < 4; ++j) { pg1[j] = __shfl_up(UG(7)[j], 1, 16); pg2[j] = __shfl_up(UG(6)[j], 1, 16); pv1[j] = __shfl_up(UV(7)[j], 1, 16); pv2[j] = __shfl_up(UV(6)[j], 1, 16); }
            if (fr == 0) { pg1 = (f32x4){0.f, 0.f, 0.f, 0.f}; pg2 = pg1; pv1 = pg1; pv2 = pg1; }
            if (fr == 0) { float* p = UH + ((size_t)(blk * 4 + 0) * 2) * FF + ch; *(f32x4*)p = UG(0); *(f32x4*)(p + FF) = UV(0); *(f32x4*)(p + 2 * FF) = UG(1); *(f32x4*)(p + 3 * FF) = UV(1); }
            if (fr == 15) { float* p = UH + ((size_t)(blk * 4 + 2) * 2) * FF + ch; *(f32x4*)p = UG(6); *(f32x4*)(p + FF) = UV(6); *(f32x4*)(p + 2 * FF) = UG(7); *(f32x4*)(p + 3 * FF) = UV(7); }
            const f32x4 w0g = *(const f32x4*)(cw + ch), w1g = *(const f32x4*)(cw + FF2 + ch), w2g = *(const f32x4*)(cw + 2 * FF2 + ch), bg = *(const f32x4*)(cb + ch);
            const f32x4 w0v = *(const f32x4*)(cw + FF + ch), w1v = *(const f32x4*)(cw + FF2 + FF + ch), w2v = *(const f32x4*)(cw + 2 * FF2 + FF + ch), bv = *(const f32x4*)(cb + FF + ch);
#pragma unroll
            for (int rr = 7; rr >= 0; --rr) {
                const f32x4 g1 = rr >= 1 ? UG(rr >= 1 ? rr - 1 : 0) : pg1, g2 = rr >= 2 ? UG(rr >= 2 ? rr - 2 : 0) : (rr == 1 ? pg1 : pg2);
                const f32x4 v1 = rr >= 1 ? UV(rr >= 1 ? rr - 1 : 0) : pv1, v2 = rr >= 2 ? UV(rr >= 2 ? rr - 2 : 0) : (rr == 1 ? pv1 : pv2);
                const f32x4 yg = bg + w0g * UG(rr) + w1g * g1 + w2g * g2, yv = bv + w0v * UV(rr) + w1v * v1 + w2v * v2;
                typedef unsigned u32x2 __attribute__((ext_vector_type(2)));
                u32x2 w; w.x = cvt_pk_bf16(silu_f(yg[0]) * yv[0], silu_f(yg[1]) * yv[1]); w.y = cvt_pk_bf16(silu_f(yg[2]) * yv[2], silu_f(yg[3]) * yv[3]);
                if (n == 0) { keep[rr][0] = w.x; keep[rr][1] = w.y; }
                else { u32x4 w4; w4.x = keep[rr][0]; w4.y = keep[rr][1]; w4.z = w.x; w4.w = w.y; *(u32x4*)(G + gtile + (size_t)((fr * 8 + rr + wr * HALF) * 64)) = w4; }
            }
#undef UG
#undef UV
        }
    }
};
}

namespace fa {
constexpr int D = 128, LD = DM, NW = 8, QBLK = 32, KVBLK = 64, QB = NW * QBLK;
constexpr int SHM_V = KVBLK * D * 2, SHM_K = KVBLK * D * 2;
constexpr int LDS_WS = 2 * SHM_V + 2 * SHM_K, LDS_CB = LDS_WS + NW * 64 * 4, ATT_LDS_BYTES = LDS_CB + 2 * 64 * 4;
constexpr float THR = 16.f, SCALE = ATT_SCALE;
#define KSWZ(row, colB) ((row) * 256 + ((colB) ^ (((row) & 7) << 4)))
#define SBAR() __builtin_amdgcn_sched_barrier(0)
__device__ __forceinline__ int v_st(int k, int c) { const int kk = (k & ~0xC) | ((k & 4) << 1) | ((k & 8) >> 1); return ((kk >> 3) * 4 + (c >> 5)) * 512 + ((kk & 7) * 32 + (c & 31)) * 2; }
__device__ __forceinline__ int v_rd_base(int lane) { return ((lane & 3) << 3) | (((lane >> 2) & 3) << 6) | (((lane >> 4) & 1) << 5) | (((lane >> 5) & 1) << 8); }
constexpr int v_rd_off(int d0, int ks, int half) { return d0 * 512 + ks * 4096 + half * 2048; }
__device__ __forceinline__ int crow(int r, int hi) { return (r & 3) + 8 * (r >> 2) + 4 * hi; }
__device__ __forceinline__ bf16x8 load8(const bf16_t* p) { return *reinterpret_cast<const bf16x8*>(p); }
__device__ __forceinline__ void mask_tile(f32x16& p0, f32x16& p1, int dq, unsigned W) {
    const float NEG = -__builtin_inff();
#pragma unroll
    for (int r = 0; r < 16; ++r) {
        const int c = (r & 3) + 8 * (r >> 2);
        if ((unsigned)(dq - c) >= W) p0[r] = NEG;
        if ((unsigned)(dq - c - 32) >= W) p1[r] = NEG;
    }
}
__device__ __forceinline__ void partialSM(f32x16& p0, f32x16& p1, float& m_reg, float& mn, float& alpha) {
    float pmax = p0[0]; for (int r = 1; r < 16; ++r) pmax = fmaxf(pmax, p0[r]); for (int r = 0; r < 16; ++r) pmax = fmaxf(pmax, p1[r]);
    { auto rr = __builtin_amdgcn_permlane32_swap(__float_as_uint(pmax), __float_as_uint(pmax), false, false);
      pmax = fmaxf(__uint_as_float(rr[0]), __uint_as_float(rr[1])); }
    constexpr float C2 = 1.4426950408889634f * SCALE;
    if (__builtin_expect(__all((pmax - m_reg) * SCALE <= THR), 1)) { mn = m_reg; alpha = 1.f; }
    else { mn = fmaxf(m_reg, pmax); alpha = __builtin_amdgcn_exp2f((m_reg - mn) * C2); m_reg = mn; }
    const float mnL = -mn * C2;
    for (int r = 0; r < 16; ++r) p0[r] = fmaf(p0[r], C2, mnL); for (int r = 0; r < 16; ++r) p1[r] = fmaf(p1[r], C2, mnL);
    for (int r = 0; r < 16; ++r) p0[r] = __builtin_amdgcn_exp2f(p0[r]);
}
__device__ __forceinline__ void finishSM(f32x16& p0, f32x16& p1, float alpha, float& l_reg, bf16x8& pa0, bf16x8& pa1, bf16x8& pa2, bf16x8& pa3) {
    for (int r = 0; r < 16; ++r) p1[r] = __builtin_amdgcn_exp2f(p1[r]);
    float ps = 0; for (int r = 0; r < 16; ++r) ps += p0[r]; for (int r = 0; r < 16; ++r) ps += p1[r];
    { auto rr = __builtin_amdgcn_permlane32_swap(__float_as_uint(ps), __float_as_uint(ps), false, false);
      ps = __uint_as_float(rr[0]) + __uint_as_float(rr[1]); }
    l_reg = l_reg * alpha + ps;
#define PK4(P, B_, OUT) do { unsigned a0 = cvt_pk_bf16(P[B_+0], P[B_+1]), a1 = cvt_pk_bf16(P[B_+2], P[B_+3]);                          \
        unsigned b0 = cvt_pk_bf16(P[B_+4], P[B_+5]), b1 = cvt_pk_bf16(P[B_+6], P[B_+7]);                                             \
        auto r0 = __builtin_amdgcn_permlane32_swap(a0, b0, false, false); auto r1 = __builtin_amdgcn_permlane32_swap(a1, b1, false, false); \
        u32x4 w = {r0[0], r1[0], r0[1], r1[1]}; OUT = *reinterpret_cast<bf16x8*>(&w); } while (0)
    PK4(p0, 0, pa0); PK4(p0, 8, pa1); PK4(p1, 0, pa2); PK4(p1, 8, pa3);
#undef PK4
}
template <int KB>
__device__ __forceinline__ void qkt(f32x16& p0, f32x16& p1, const char* K_lds, const float* cbl, int r32, int hi, const bf16x8* qr) {
#pragma unroll
    for (int g4 = 0; g4 < 4; ++g4) { const f32x4 c0 = *(const f32x4*)(cbl + KB * 64 + 8 * g4 + 4 * hi), c1 = *(const f32x4*)(cbl + KB * 64 + 32 + 8 * g4 + 4 * hi);
#pragma unroll
        for (int j = 0; j < 4; ++j) { p0[4 * g4 + j] = c0[j]; p1[4 * g4 + j] = c1[j]; } }
    const char* kb[4];
#pragma unroll
    for (int dd = 0; dd < 4; ++dd) kb[dd] = K_lds + KB * SHM_K + KSWZ(r32, (dd * 16 + hi * 8) * 2);
#pragma unroll
    for (int d0 = 0; d0 < 8; ++d0) { const char* a = kb[d0 & 3] + (d0 >> 2) * 128;
        bf16x8 b0 = *reinterpret_cast<const bf16x8*>(a);
        bf16x8 b1 = *reinterpret_cast<const bf16x8*>(a + 32 * 256);
        p0 = __builtin_amdgcn_mfma_f32_32x32x16_bf16(b0, qr[d0], p0, 0, 0, 0);
        p1 = __builtin_amdgcn_mfma_f32_32x32x16_bf16(b1, qr[d0], p1, 0, 0, 0); }
}
template <int VB>
__device__ __forceinline__ void pv_tile(f32x16* o, int vb0, bf16x8 pa0, bf16x8 pa1, bf16x8 pa2, bf16x8 pa3) {
#define TRRD(dst, off) asm volatile("ds_read_b64_tr_b16 %0, %1 offset:%2" : "=&v"(dst) : "v"(vb0), "i"(off) : "memory")
#define PV_D0(d0) do { s16x4 l0, l1, l2, l3, h0, h1, h2, h3; constexpr int b_ = VB * SHM_V + v_rd_off(d0, 0, 0); \
        TRRD(l0, b_); TRRD(h0, b_ + 2048); TRRD(l1, b_ + 4096); TRRD(h1, b_ + 6144); TRRD(l2, b_ + 8192); TRRD(h2, b_ + 10240); TRRD(l3, b_ + 12288); TRRD(h3, b_ + 14336); \
        asm volatile("s_waitcnt lgkmcnt(0)" ::: "memory"); SBAR();   \
        o[d0] = __builtin_amdgcn_mfma_f32_32x32x16_bf16(pa0, (bf16x8){l0[0], l0[1], l0[2], l0[3], h0[0], h0[1], h0[2], h0[3]}, o[d0], 0, 0, 0);   \
        o[d0] = __builtin_amdgcn_mfma_f32_32x32x16_bf16(pa1, (bf16x8){l1[0], l1[1], l1[2], l1[3], h1[0], h1[1], h1[2], h1[3]}, o[d0], 0, 0, 0);   \
        o[d0] = __builtin_amdgcn_mfma_f32_32x32x16_bf16(pa2, (bf16x8){l2[0], l2[1], l2[2], l2[3], h2[0], h2[1], h2[2], h2[3]}, o[d0], 0, 0, 0);   \
        o[d0] = __builtin_amdgcn_mfma_f32_32x32x16_bf16(pa3, (bf16x8){l3[0], l3[1], l3[2], l3[3], h3[0], h3[1], h3[2], h3[3]}, o[d0], 0, 0, 0); } while (0)
    PV_D0(0); PV_D0(1); PV_D0(2); PV_D0(3);
#undef PV_D0
#undef TRRD
}
struct BlockRef { const bf16_t* Q; const bf16_t* K; const bf16_t* V; const float* CB; bf16_t* O; int P0; };
struct Seam { bf16x8 qr[8]; bf16x8 st_v0, st_v1, st_k0, st_k1; };
#define ROW(p, k0, rr) ((p) + (size_t)((k0) + (rr)) * LD + sc)
#define VMW() asm volatile("s_waitcnt vmcnt(0)" ::: "memory")
#define VMWN(n) asm volatile("s_waitcnt vmcnt(%0)" :: "i"(n) : "memory")
#define SLOAD_H(Kp, Vp, Cp, k0, bf) do { if (wid == 0) __builtin_amdgcn_global_load_lds((const unsigned*)((Cp) + (k0) + lane), (LAS unsigned*)(cbd + (bf) * 64), 4, 0, 0); \
                         S.st_v0 = load8(ROW(Vp, k0, sr)); S.st_v1 = load8(ROW(Vp, k0, 32 + sr));              \
                         S.st_k0 = load8(ROW(Kp, k0, sr)); S.st_k1 = load8(ROW(Kp, k0, 32 + sr)); } while (0)
#define SWRITE_HK(bf) do { *(bf16x8*)(K_lds + (bf) * SHM_K + kws) = S.st_k0; *(bf16x8*)(K_lds + (bf) * SHM_K + kws + 32 * 256) = S.st_k1; } while (0)
#define SWRITE_HV(bf) do { *(bf16x8*)(V_lds + (bf) * SHM_V + vst0) = S.st_v0; *(bf16x8*)(V_lds + (bf) * SHM_V + vst1) = S.st_v1; } while (0)
#define SWRITE_H(bf) do { SWRITE_HV(bf); SWRITE_HK(bf); } while (0)
__device__ __forceinline__ void prime(const BlockRef& cur, char* lds, LAS float* cbd, Seam& S) {
    int tid = threadIdx.x; asm volatile("" : "+v"(tid));
    const int wid = __builtin_amdgcn_readfirstlane(tid >> 6), lane = tid & 63, r32 = lane & 31, hi = lane >> 5;
    const int sr = tid >> 4, sc = (tid & 15) * 8, kws = KSWZ(sr, sc * 2); char* K_lds = lds + 2 * SHM_V;
    for (int d0 = 0; d0 < 8; ++d0) S.qr[d0] = load8(cur.Q + (size_t)(wid * QBLK + r32) * LD + d0 * 16 + hi * 8);
    SLOAD_H(cur.K, cur.V, cur.CB, ((cur.P0 + QB - 1) / KVBLK) * KVBLK, 0); VMW(); SWRITE_HK(0);
    __syncthreads();
}
__device__ __forceinline__ void block(const BlockRef& cur, const BlockRef& nxt, char* lds, LAS float* cbd, Seam& S) {
    int tid = threadIdx.x; asm volatile("" : "+v"(tid));
    const int wid = __builtin_amdgcn_readfirstlane(tid >> 6), lane = tid & 63, r32 = lane & 31, hi = lane >> 5;
    constexpr int W = SEQ;
    const int NT = (cur.P0 + QB - 1) / KVBLK + 1;
    const int kbn = ((nxt.P0 + QB - 1) / KVBLK) * KVBLK;
    const int qlo = cur.P0 + wid * QBLK, qm = qlo + r32 - 4 * hi;
    char* V_lds = lds; char* K_lds = lds + 2 * SHM_V; float* cbl = (float*)(lds + LDS_CB);
    float* ws = (float*)(lds + LDS_WS) + wid * 64; float* li_l = ws, * al_l = ws + 32;
    float m_reg = -1e30f, l_reg = 0; f32x16 o[4] = {};
    const int sr = tid >> 4, sc = (tid & 15) * 8, vst0 = v_st(sr, sc), vst1 = v_st(32 + sr, sc), kws = KSWZ(sr, sc * 2);
    const int vb0 = (int)(uintptr_t)V_lds + v_rd_base(lane);
    const bf16_t* Kh = cur.K; const bf16_t* Vh = cur.V; const float* Ch = cur.CB;
#define RESC(a) do { if (__any((a) < 1.f)) { if (hi == 0) al_l[r32] = (a); asm volatile("s_waitcnt lgkmcnt(0)" ::: "memory");              \
                     for (int d_ = 0; d_ < 4; ++d_) for (int r = 0; r < 16; ++r) o[d_][r] *= al_l[crow(r, hi)]; } } while (0)
#define KBASE(t) ((NT - 1 - (t)) * KVBLK)
#define MASKT(P0_, P1_, t) do { const int kb_ = KBASE(t); if (kb_ + KVBLK - 1 > qlo) mask_tile(P0_, P1_, qm - kb_, (unsigned)W); } while (0)
    constexpr int NQL = 8;
#define SEAM_K0() do { VMWN(NQL); SWRITE_HK(0); SBAR(); } while (0)
    f32x16 pA0, pA1, pB0, pB1; float mnA, mnB, alA, alB; bf16x8 pa0, pa1, pa2, pa3;
    SWRITE_HV(0); SBAR();
    if (NT > 1) { SLOAD_H(Kh, Vh, Ch, KBASE(1), 1); }
    SBAR(); qkt<0>(pA0, pA1, K_lds, cbl, r32, hi, S.qr);
    MASKT(pA0, pA1, 0); partialSM(pA0, pA1, m_reg, mnA, alA);
    if (NT > 1) { VMW(); SWRITE_H(1); }
    __syncthreads();
#define HALF_STEP(PX0, PX1, mnX, alX, PY0, PY1, alY, t, KB, VB, SB) do {                                                      \
        SBAR(); qkt<KB>(PX0, PX1, K_lds, cbl, r32, hi, S.qr);                                                                 \
        finishSM(PY0, PY1, alY, l_reg, pa0, pa1, pa2, pa3); SBAR();                                                           \
        if ((t) + 1 < NT) { SLOAD_H(Kh, Vh, Ch, KBASE((t) + 1), SB); SBAR(); }                                                    \
        pv_tile<VB>(o, vb0, pa0, pa1, pa2, pa3); MASKT(PX0, PX1, (t)); partialSM(PX0, PX1, m_reg, mnX, alX);                  \
        __syncthreads();                                                                                                      \
        if ((t) + 1 < NT) { VMW(); SWRITE_H(SB); }                                                                            \
        RESC(alX); __syncthreads(); } while (0)
    for (int t = 1; t + 1 < NT; t += 2) {
        HALF_STEP(pB0, pB1, mnB, alB, pA0, pA1, alA, t, 1, 0, 0);
        HALF_STEP(pA0, pA1, mnA, alA, pB0, pB1, alB, t + 1, 0, 1, 1);
    }
    const bool even = (NT & 1) == 0;
    if (even) { SBAR(); qkt<1>(pB0, pB1, K_lds, cbl, r32, hi, S.qr); SBAR(); }
    SLOAD_H(nxt.K, nxt.V, nxt.CB, kbn, 0); SBAR();
#pragma unroll
    for (int d0 = 0; d0 < 8; ++d0) S.qr[d0] = load8(nxt.Q + (size_t)(wid * QBLK + r32) * LD + d0 * 16 + hi * 8);
    SBAR();
    finishSM(pA0, pA1, alA, l_reg, pa0, pa1, pa2, pa3); SBAR();
    pv_tile<0>(o, vb0, pa0, pa1, pa2, pa3);
    if (even) { MASKT(pB0, pB1, NT - 1); partialSM(pB0, pB1, m_reg, mnB, alB); __syncthreads(); RESC(alB);
        finishSM(pB0, pB1, alB, l_reg, pa0, pa1, pa2, pa3); SBAR(); pv_tile<1>(o, vb0, pa0, pa1, pa2, pa3); }
    SBAR(); SEAM_K0();
    if (hi == 0) li_l[r32] = l_reg; asm volatile("s_waitcnt lgkmcnt(0)" ::: "memory");
    float rli[16];
#pragma unroll
    for (int r = 0; r < 16; ++r) rli[r] = __builtin_amdgcn_rcpf(li_l[crow(r, hi)]);
    bf16_t* Ow = cur.O + (size_t)(wid * QBLK) * LD;
#pragma unroll
    for (int r = 0; r < 16; ++r) { const int orow = crow(r, hi);
#pragma unroll
        for (int d0 = 0; d0 < 4; ++d0) { const float v = o[d0][r] * rli[r];
            const float vn = __shfl_xor(v, 1);
            if ((r32 & 1) == 0) *(unsigned*)(Ow + (size_t)orow * LD + d0 * 32 + r32) = cvt_pk_bf16(v, vn); } }
    __syncthreads();
#undef RESC
#undef KBASE
#undef MASKT
#undef SEAM_K0
#undef HALF_STEP
}
#undef ROW
#undef VMW
#undef VMWN
#undef SLOAD_H
#undef SWRITE_HK
#undef SWRITE_HV
#undef SWRITE_H
__device__ __forceinline__ BlockRef make_ref(int L, int pass, const bf16_t* Q, const bf16_t* K, const bf16_t* V, const float* CB, bf16_t* O) {
    const int bh = L >> 2, x = L & 3, qb = pass ? 7 - x : x, b = bh / NH, h = bh % NH;
    BlockRef r; const size_t rowoff = ((size_t)b * SEQ) * LD + (size_t)h * D;
    r.Q = Q + rowoff + (size_t)qb * QB * LD; r.O = O + rowoff + (size_t)qb * QB * LD; r.K = K + rowoff; r.V = V + rowoff; r.CB = CB + (size_t)bh * SEQ; r.P0 = qb * QB;
    return r;
}
__device__ __forceinline__ void attn_phase(char* lds, LAS float* cbd, const bf16_t* Q, const bf16_t* K, const bf16_t* V, const float* CB, bf16_t* O) {
    const int total = NB * NH * 4, stride = gridDim.x;
    int L = blockIdx.x; if (L >= total) return;
    int pass = 0;
    BlockRef cur = make_ref(L, 0, Q, K, V, CB, O);
    Seam S;
    prime(cur, lds, cbd, S);
    for (;;) {
        const bool more_pass = pass == 0, more_item = L + stride < total, last = !more_pass && !more_item;
        int passn = pass + 1, Ln = L;
        if (!more_pass) { passn = 0; Ln = more_item ? L + stride : L; }
        const BlockRef nxt = last ? cur : make_ref(Ln, passn, Q, K, V, CB, O);
        block(cur, nxt, lds, cbd, S);
        if (last) break;
        cur = nxt; pass = passn; L = Ln;
    }
}
#undef KSWZ
#undef SBAR
}

struct Args { const float* in[15]; float* out; unsigned char* ws; int ph_lo, ph_hi, one, pad; };
typedef const __attribute__((address_space(4))) Args* KArgsT;
struct TrItem { const float* src; const float* gk; const float* gn; bf16_t* dst; int K, N, upmap, k0, n0; };
__device__ __forceinline__ TrItem tr_decode(int it, KArgsT ap) {
    constexpr int I_POOL = 8 * 16 * 16, I_KVF = 64 * 129, I_SQ = 64 * 64, I_UP = 64 * 344, I_DN = 172 * 64;
    TrItem t; int r = it;
    if (r < I_POOL) { const int mat = r >> 8, q = r & 255;
        t.src = ap->in[3] + (size_t)mat * 1024 * 1024; t.gk = nullptr; t.gn = ap->in[4] + (size_t)mat * 1024; t.dst = (bf16_t*)(ap->ws + WS_WP) + (size_t)mat * 1024 * 1024; t.K = 1024; t.N = 1024; t.upmap = 0; t.k0 = 64 * (q >> 4); t.n0 = 64 * (q & 15); return t; }
    r -= I_POOL;
    if (r < I_KVF) { t.src = ap->in[6]; t.gk = ap->in[5]; t.gn = nullptr; t.dst = (bf16_t*)(ap->ws + WS_WKVF); t.K = DM; t.N = NKVF; t.upmap = 0; t.k0 = 64 * (r / 129); t.n0 = 64 * (r % 129); return t; }
    r -= I_KVF;
    if (r < 4 * I_SQ) { const int mat = r / I_SQ, q = r % I_SQ;
        if (mat < 2) { t.src = ap->in[8] + (size_t)mat * DM * DM; t.gk = ap->in[1] + (size_t)(2 + mat) * DM; t.dst = (bf16_t*)(ap->ws + WS_WQ) + (size_t)mat * DM * DM; }
        else { t.src = ap->in[9] + (size_t)(mat - 2) * DM * DM; t.gk = nullptr; t.dst = (bf16_t*)(ap->ws + WS_WO) + (size_t)(mat - 2) * DM * DM; }
        t.gn = nullptr; t.K = DM; t.N = DM; t.upmap = 0; t.k0 = 64 * (q >> 6); t.n0 = 64 * (q & 63); return t; }
    r -= 4 * I_SQ;
    if (r < 4 * I_UP) { const int l = r / I_UP, q = r % I_UP;
        t.src = ap->in[10] + (size_t)l * DM * FF2; t.gk = ap->in[2] + (size_t)l * DM; t.gn = nullptr; t.dst = (bf16_t*)(ap->ws + WS_WUP) + (size_t)l * FF2 * DM; t.K = DM; t.N = FF2; t.upmap = 1; t.k0 = 64 * (q / 344); t.n0 = 64 * (q % 344); return t; }
    r -= 4 * I_UP;
    { const int l = r / I_DN, q = r % I_DN;
      t.src = ap->in[13] + (size_t)l * FF * DM; t.gk = nullptr; t.gn = nullptr; t.dst = (bf16_t*)(ap->ws + WS_WDN) + (size_t)l * DM * FF; t.K = FF; t.N = DM; t.upmap = 0; t.k0 = 64 * (q >> 6); t.n0 = 64 * (q & 63); return t; }
}
__device__ __forceinline__ void tr_load(const TrItem& t, float (&v)[64], int lane) {
    const bool nok = (t.n0 + lane) < t.N; const float* p = t.src + (size_t)t.k0 * t.N + t.n0 + lane;
#pragma unroll
    for (int i = 0; i < 64; ++i) v[i] = nok ? p[(size_t)i * t.N] : 0.f;
}
__device__ __forceinline__ void tr_emit(const TrItem& t, const float (&v)[64], LAS float* scr, int lane) {
    const float gnv = (t.gn && (t.n0 + lane) < t.N) ? t.gn[t.n0 + lane] : 1.f;
#pragma unroll
    for (int i = 0; i < 64; ++i) { const float gkv = t.gk ? t.gk[t.k0 + i] : 1.f; scr[i * 65 + lane] = v[i] * (gkv * gnv); }
    asm volatile("s_waitcnt lgkmcnt(0)" ::: "memory");
    const int c = lane & 7;
#pragma unroll
    for (int j = 0; j < 8; ++j) { const int n = (lane >> 3) + 8 * j; const LAS float* sp = scr + (8 * c) * 65 + n;
        u32x4 o; o.x = cvt_pk_bf16(sp[0 * 65], sp[1 * 65]); o.y = cvt_pk_bf16(sp[2 * 65], sp[3 * 65]); o.z = cvt_pk_bf16(sp[4 * 65], sp[5 * 65]); o.w = cvt_pk_bf16(sp[6 * 65], sp[7 * 65]);
        const int ng = t.n0 + n; int nd = ng;
        if (t.upmap) { const int isv = ng >= FF ? 1 : 0, ch = ng - isv * FF; nd = 256 * (ch >> 7) + 128 * isv + (ch & 127); }
        if (ng < t.N) *(u32x4*)(t.dst + ((size_t)(nd >> 8) * (t.K >> 6) + (t.k0 >> 6)) * 16384 + (nd & 255) * 64 + 8 * c) = o; }
    asm volatile("s_waitcnt lgkmcnt(0)" ::: "memory");
}

typedef KArgsT KArgs;
__device__ __forceinline__ KArgs kargs() { unsigned long long p = (unsigned long long)__builtin_amdgcn_kernarg_segment_ptr(); asm volatile("" : "+s"(p)); return (KArgs)p; }
__device__ __forceinline__ int otid() { int t = threadIdx.x; asm volatile("" : "+v"(t)); return t; }
__device__ __forceinline__ bool in_ph(int ph) { KArgs ap = kargs(); return ap->ph_lo <= ph && ph < ap->ph_hi; }
__device__ __forceinline__ void seam(int ph, LAS unsigned char* lds) {
    KArgs ap = kargs();
    if (ap->one && ph + 1 < ap->ph_hi) { XcdBarrier b; b.bar = (unsigned*)(ap->ws + WS_CTL); b.x = xb_xcc_id(); b.st = (volatile LAS unsigned*)(lds + LDSCTL_OFF); xcd_barrier(b); }
}

__device__ __forceinline__ void seam_force(LAS unsigned char* lds) {
    KArgs ap = kargs();
    if (ap->one) { XcdBarrier b; b.bar = (unsigned*)(ap->ws + WS_CTL); b.x = xb_xcc_id(); b.st = (volatile LAS unsigned*)(lds + LDSCTL_OFF); xcd_barrier(b); }
}
__global__ void __launch_bounds__(NTHREADS, 2) fwd(Args a_) {
    extern __shared__ __attribute__((aligned(16))) unsigned char lds_raw[];
    LAS unsigned char* lds = (LAS unsigned char*)lds_raw;
    { const int tid = otid(); if (tid < 64) ((LAS unsigned*)(lds + LDSCTL_OFF))[tid] = 0u; }
    __syncthreads();
    { KArgs ap = kargs(); if (ap->one) (void)xcd_barrier_post((unsigned*)(ap->ws + WS_CTL), (volatile LAS unsigned*)(lds + LDSCTL_OFF)); }
    int ph = 0;
#ifndef PH_MASK
#define PH_MASK 0xFFF
#endif
#define SITE(n) (((PH_MASK) >> (n)) & 1)
#ifndef REP_MASK
#define REP_MASK 0
#endif
#ifndef FAKE_DRY
#define FAKE_DRY 0
#endif
#ifndef NULL_EPI
#define NULL_EPI 0
#endif
#ifndef WGM_DOWN
#define WGM_DOWN 2
#endif
#ifndef MF32_DRY
#define MF32_DRY 0
#endif
#define NREP(n) ((((REP_MASK) >> (n)) & 1) ? 2 : 1)
#define REPLOOP(n) _Pragma("nounroll") for (int rep = 0; rep < NREP(n); ++rep)
#define REPBAR(n) do { if (NREP(n) > 1 && rep + 1 < NREP(n)) seam_force(lds); } while (0)
#define SEAM() do { seam(ph, lds); ++ph; } while (0)
#define WSP(T, off) ((T*)(ap->ws + (off)))
#define FINALIZE() do { if (in_ph(ph)) { KArgs ap = kargs(); const int tid = otid(); const float* SLOTS = WSP(float, WS_SLOTS); float* RSTD = WSP(float, WS_RSTD); \
        for (int i = blockIdx.x * NTHREADS + tid; i < MTOK * 8; i += gridDim.x * NTHREADS) { const f32x4* p = (const f32x4*)(SLOTS + (size_t)i * 8); const f32x4 u0 = p[0], u1 = p[1]; \
            float sq = ((u0[0] + u0[1]) + (u0[2] + u0[3])) + ((u1[0] + u1[1]) + (u1[2] + u1[3])); sq += __shfl_xor(sq, 1); sq += __shfl_xor(sq, 2); sq += __shfl_xor(sq, 4); \
            if ((i & 7) == 0) RSTD[i >> 3] = 1.0f / sqrtf(sq * (1.0f / DM) + EPS); } } SEAM(); } while (0)

    if (SITE(0) && in_ph(ph)) REPLOOP(0) {
        KArgs ap = kargs(); const int tid = otid(), lane = tid & 63, wave = __builtin_amdgcn_readfirstlane(tid >> 6), G = gridDim.x, bx = blockIdx.x, gw = bx * NWAVES + wave, NGW = G * NWAVES;
        const float* x = ap->in[0]; bf16_t* WkvfT = WSP(bf16_t, WS_WKVF); float* RSTD = WSP(float, WS_RSTD);
        LAS float* scr = (LAS float*)(lds + wave * 16640);
        constexpr int NITEMS = 8 * 16 * 16 + 64 * 129 + 4 * 64 * 64 + 4 * 64 * 344 + 4 * 172 * 64;
        { float va[64], vb[64]; int it = gw;
          if (it < NITEMS) { TrItem ta = tr_decode(it, ap); tr_load(ta, va, lane);
            for (;;) {
                const int itb = it + NGW; const bool hb_ = itb < NITEMS; TrItem tb = ta;
                if (hb_) { tb = tr_decode(itb, ap); tr_load(tb, vb, lane); }
                tr_emit(ta, va, scr, lane);
                if (!hb_) break;
                const int itc = itb + NGW; const bool hc_ = itc < NITEMS;
                if (hc_) { ta = tr_decode(itc, ap); tr_load(ta, va, lane); }
                tr_emit(tb, vb, scr, lane);
                if (!hc_) break;
                it = itc;
            } } }
        for (int i = bx * NTHREADS + tid; i < (NKVFP - NKVF) * (DM / 8); i += G * NTHREADS) { const int kt = i / ((NKVFP - NKVF) * 8), rem = i % ((NKVFP - NKVF) * 8), r = rem >> 3, c = rem & 7;
            *(u32x4*)(WkvfT + ((size_t)32 * (DM / 64) + kt) * 16384 + (32 + r) * 64 + c * 8) = (u32x4){0u, 0u, 0u, 0u}; }
        for (int m = gw; m < MTOK; m += NGW) { const f32x4* xr = (const f32x4*)(x + (size_t)m * DM) + lane; float sq = 0.f;
            typedef unsigned u32x2 __attribute__((ext_vector_type(2))); u32x2* hbr = (u32x2*)(WSP(bf16_t, WS_HB) + (size_t)m * DM) + lane;
#pragma unroll
            for (int j = 0; j < 16; ++j) { const f32x4 v = xr[64 * j]; sq += (v[0] * v[0] + v[1] * v[1]) + (v[2] * v[2] + v[3] * v[3]); u32x2 w; w.x = cvt_pk_bf16(v[0], v[1]); w.y = cvt_pk_bf16(v[2], v[3]); hbr[64 * j] = w; }
            sq = wave_sum(sq); if (lane == 0) RSTD[m] = 1.0f / sqrtf(sq * (1.0f / DM) + EPS); }
        REPBAR(0);
    }
    SEAM();


#ifdef MFMA_PROBE
    {
        const int tid = otid(); KArgs ap = kargs();
        bf16x8 pa, pb;
#pragma unroll
        for (int j = 0; j < 8; ++j) { pa[j] = (short)(0x3f80 + ((tid * 7 + j * 13) & 0x7f) + ((tid & 1) << 15)); pb[j] = (short)(0x3c00 + ((tid * 5 + j * 11) & 0x7f) + ((j & 1) << 15)); }
        f32x4 c[8];
#pragma unroll
        for (int j = 0; j < 8; ++j) c[j] = (f32x4){0.f, 0.f, 0.f, 0.f};
#pragma nounroll
        for (int i = 0; i < 25000; ++i) {
#pragma unroll
            for (int j = 0; j < 8; ++j) c[j] = __builtin_amdgcn_mfma_f32_16x16x32_bf16(pa, pb, c[j], 0, 0, 0);
        }
        float sum = 0.f;
#pragma unroll
        for (int j = 0; j < 8; ++j) sum += c[j][0] + c[j][1] + c[j][2] + c[j][3];
        if (sum == 12345.678f) WSP(float, WS_DUM_SLOTS)[tid] = sum;
    }
#endif
#pragma nounroll
    for (int l = 0; l < 4; ++l) {
        if (l < 2) {
            if (SITE(1) && in_ph(ph)) REPLOOP(1) {
                KArgs ap = kargs(); const int tid = otid(), G = gridDim.x, bx = blockIdx.x;
                const bf16_t* hin = WSP(bf16_t, WS_HB); const float* RSTD = WSP(float, WS_RSTD); const float* SLOTS = WSP(float, WS_SLOTS); bf16_t* X1 = WSP(bf16_t, WS_X1);
                LAS float* rs = (LAS float*)lds;
                const float* gn = ap->in[1] + (size_t)l * DM;
                for (int chunk = bx; chunk < MTOK / 64; chunk += G) {
                    const int r0 = chunk * 64, t0 = r0 % SEQ;
                    __syncthreads();
                    if (l == 0) { if (tid < 80) rs[tid] = (t0 - 16 + tid >= 0) ? RSTD[r0 - 16 + tid] : 0.f; }
                    else {
#pragma unroll
                        for (int pass = 0; pass < 2; ++pass) { const int i = pass * 64 + (tid >> 3), part = tid & 7;
                            float sq = 0.f; const bool ok = (i < 80) && (t0 - 16 + i >= 0);
                            if (ok) { const f32x4* p = (const f32x4*)(SLOTS + (size_t)(r0 - 16 + i) * 64 + part * 8); const f32x4 u0 = p[0], u1 = p[1]; sq = ((u0[0] + u0[1]) + (u0[2] + u0[3])) + ((u1[0] + u1[1]) + (u1[2] + u1[3])); }
                            sq += __shfl_xor(sq, 1); sq += __shfl_xor(sq, 2); sq += __shfl_xor(sq, 4);
                            if (part == 0 && i < 80) rs[i] = ok ? 1.0f / sqrtf(sq * (1.0f / DM) + EPS) : 0.f; } }
                    __syncthreads();
                    const int c0 = tid * 8, w = 2 << (tid >> 7);
                    const f32x4 g0 = *(const f32x4*)(gn + c0), g1 = *(const f32x4*)(gn + c0 + 4);
                    f32x4 s0 = {0.f, 0.f, 0.f, 0.f}, s1 = s0;
                    for (int j = 1; j < w; ++j) { if (t0 - j >= 0) { const u32x4 hw = *(const u32x4*)(hin + (size_t)(r0 - j) * DM + c0); const float r = rs[16 - j]; s0 += pg8::bf_lo4(hw) * r; s1 += pg8::bf_hi4(hw) * r; } }
                    for (int i0 = 0; i0 < 64; i0 += 4) {
                        u32x4 nw[4], ow[4];
#pragma unroll
                        for (int k = 0; k < 4; ++k) { nw[k] = *(const u32x4*)(hin + (size_t)(r0 + i0 + k) * DM + c0);
                            const int to = t0 + i0 + k - w + 1;
                            if (to >= 0) ow[k] = *(const u32x4*)(hin + (size_t)(r0 + i0 + k - w + 1) * DM + c0); else ow[k] = (u32x4){0u, 0u, 0u, 0u}; }
#pragma unroll
                        for (int k = 0; k < 4; ++k) { const int i = i0 + k; const float r = rs[16 + i];
                            const f32x4 n0 = pg8::bf_lo4(nw[k]) * r, n1 = pg8::bf_hi4(nw[k]) * r;
                            s0 += n0; s1 += n1;
                            const int t = t0 + i; const float inv = 1.0f / (float)(t + 1 < w ? t + 1 : w);
                            const f32x4 m0 = g0 * (s0 * inv - n0), m1 = g1 * (s1 * inv - n1);
                            *(u32x4*)(X1 + (size_t)(r0 + i) * DM + c0) = pack8u(m0, m1);
                            if (t - w + 1 >= 0) { const float rq = rs[16 + i - w + 1]; s0 -= pg8::bf_lo4(ow[k]) * rq; s1 -= pg8::bf_hi4(ow[k]) * rq; } }
                    }
                }
                REPBAR(1);
            }
            SEAM();
            if (SITE(2) && in_ph(ph)) REPLOOP(2) {
                KArgs ap = kargs(); const bool dry = rep + 1 < NREP(2);
                pg8::Gemm g{WSP(bf16_t, WS_X1), WSP(bf16_t, WS_WP) + (size_t)l * DM * 1024, MTOK, DM, 1024, DM, 1}; pg8::StaticOrder SO; SO.init(MTOK, DM, gridDim.x, blockIdx.x);
                pg8::EpiRes E{WSP(bf16_t, WS_HB), dry ? WSP(bf16_t, WS_DUM_HB) : WSP(bf16_t, WS_HB), dry ? WSP(float, WS_DUM_SLOTS) : WSP(float, WS_SLOTS)};
                pg8::gemm_phase<pg8::EpiRes, false>(lds, g, SO, E);
                REPBAR(2);
            }
            SEAM();
            FINALIZE();
        } else {
            if (l == 2) {
                if (SITE(3) && in_ph(ph)) REPLOOP(3) {
                    KArgs ap = kargs();
                    pg8::Gemm g{WSP(bf16_t, WS_HB), WSP(bf16_t, WS_WKVF), MTOK, NKVFP, DM, DM, 0}; pg8::StaticOrder SO; SO.init(MTOK, NKVFP, gridDim.x, blockIdx.x);
                    pg8::EpiKVF E{WSP(bf16_t, WS_KB), WSP(float, WS_RSTD)};
                    pg8::gemm_phase<pg8::EpiKVF, false>(lds, g, SO, E);
                    REPBAR(3);
                }
                SEAM();
                if (SITE(4) && in_ph(ph)) {
                    KArgs ap = kargs(); const int tid = otid(), lane = tid & 63, wave = __builtin_amdgcn_readfirstlane(tid >> 6), G = gridDim.x, bx = blockIdx.x;
                    const bf16_t* FLOG = WSP(bf16_t, WS_FLOG); float* CBIAS = WSP(float, WS_CBIAS); const float* b_f = ap->in[7];
                    if (wave == 0) for (int seq = bx; seq < NB * NH; seq += G) {
                        const int b = seq / NH, h = seq % NH; const float bf = b_f[h];
                        float v[32]; float run = 0.f;
#pragma unroll
                        for (int i = 0; i < 32; ++i) { const float z = __uint_as_float((unsigned)FLOG[((size_t)b * SEQ + lane * 32 + i) * DM + h] << 16) + bf; const float ls = fminf(z, 0.f) - log1pf(expf(-fabsf(z))); run += ls; v[i] = run; }
                        float incl = run;
#pragma unroll
                        for (int o = 1; o < 64; o <<= 1) { const float t = __shfl_up(incl, o); if (lane >= o) incl += t; }
                        const float excl = incl - run;
#pragma unroll
                        for (int i = 0; i < 32; i += 4) { f32x4 w; w[0] = -(v[i] + excl) * (1.0f / ATT_SCALE); w[1] = -(v[i + 1] + excl) * (1.0f / ATT_SCALE); w[2] = -(v[i + 2] + excl) * (1.0f / ATT_SCALE); w[3] = -(v[i + 3] + excl) * (1.0f / ATT_SCALE);
                            *(f32x4*)(CBIAS + (size_t)seq * SEQ + lane * 32 + i) = w; }
                    }
                }
                SEAM();
            }
            if (SITE(5) && in_ph(ph)) REPLOOP(5) {
                KArgs ap = kargs();
                pg8::Gemm g{WSP(bf16_t, WS_HB), WSP(bf16_t, WS_WQ) + (size_t)(l - 2) * DM * DM, MTOK, DM, DM, DM, 0}; pg8::StaticOrder SO; SO.init(MTOK, DM, gridDim.x, blockIdx.x);
                pg8::EpiQ E{WSP(bf16_t, WS_X1), WSP(float, WS_RSTD)};
                pg8::gemm_phase<pg8::EpiQ, false>(lds, g, SO, E);
                REPBAR(5);
            }
            SEAM();
            if (SITE(6) && in_ph(ph)) REPLOOP(6) { KArgs ap = kargs(); fa::attn_phase((char*)lds_raw, (LAS float*)(lds + fa::LDS_CB), WSP(bf16_t, WS_X1), WSP(bf16_t, WS_KB), WSP(bf16_t, WS_VB), WSP(float, WS_CBIAS), WSP(bf16_t, WS_X2)); REPBAR(6); }
            SEAM();
            if (SITE(7) && in_ph(ph)) REPLOOP(7) {
                KArgs ap = kargs(); const bool dry = rep + 1 < NREP(7);
                pg8::Gemm g{WSP(bf16_t, WS_X2), WSP(bf16_t, WS_WO) + (size_t)(l - 2) * DM * DM, MTOK, DM, DM, DM, 0}; pg8::StaticOrder SO; SO.init(MTOK, DM, gridDim.x, blockIdx.x);
                pg8::EpiRes E{WSP(bf16_t, WS_HB), dry ? WSP(bf16_t, WS_DUM_HB) : WSP(bf16_t, WS_HB), dry ? WSP(float, WS_DUM_SLOTS) : WSP(float, WS_SLOTS)};
                pg8::gemm_phase<pg8::EpiRes, false>(lds, g, SO, E);
                REPBAR(7);
            }
            SEAM();
            FINALIZE();
        }
        if (SITE(8) && in_ph(ph)) REPLOOP(8) {
            KArgs ap = kargs();
            const bool dry = rep + 1 < NREP(8);
            pg8::Gemm g{WSP(bf16_t, WS_HB), WSP(bf16_t, WS_WUP) + (size_t)l * FF2 * DM, MTOK, FF2, DM, DM, 0}; g.fake = (FAKE_DRY && dry) ? FAKE_DRY : 0; pg8::StaticOrder SO; SO.init(MTOK, FF2, gridDim.x, blockIdx.x, 8);
            pg8::EpiUp E{WSP(bf16_t, WS_G), WSP(float, WS_UH), WSP(float, WS_RSTD), ap->in[11] + (size_t)l * 3 * FF2, ap->in[12] + (size_t)l * FF2}; E.skip = (NULL_EPI && dry) ? 1 : 0;
            pg8::gemm_phase<pg8::EpiUp, true>(lds, g, SO, E);
            REPBAR(8);
        }
        SEAM();
        if (SITE(9) && in_ph(ph)) {
            KArgs ap = kargs(); const int tid = otid(), G = gridDim.x, bx = blockIdx.x;
            const float* cw = ap->in[11] + (size_t)l * 3 * FF2; const float* cb = ap->in[12] + (size_t)l * FF2; const float* UH = WSP(float, WS_UH); bf16_t* GB = WSP(bf16_t, WS_G);
            for (int i = bx * NTHREADS + tid; i < 128 * (FF / 4); i += G * NTHREADS) {
                const int blk = i / (FF / 4), ch = (i % (FF / 4)) * 4;
                if ((blk & 15) == 0) continue;
                const float* pc = UH + ((size_t)(blk * 4) * 2) * FF + ch; const float* pp = UH + ((size_t)((blk - 1) * 4 + 2) * 2) * FF + ch;
                const f32x4 g_2 = *(const f32x4*)pp, v_2 = *(const f32x4*)(pp + FF), g_1 = *(const f32x4*)(pp + 2 * FF), v_1 = *(const f32x4*)(pp + 3 * FF);
                const f32x4 g0 = *(const f32x4*)pc, v0 = *(const f32x4*)(pc + FF), g1 = *(const f32x4*)(pc + 2 * FF), v1 = *(const f32x4*)(pc + 3 * FF);
                const f32x4 w0g = *(const f32x4*)(cw + ch), w1g = *(const f32x4*)(cw + FF2 + ch), w2g = *(const f32x4*)(cw + 2 * FF2 + ch), bg = *(const f32x4*)(cb + ch);
                const f32x4 w0v = *(const f32x4*)(cw + FF + ch), w1v = *(const f32x4*)(cw + FF2 + FF + ch), w2v = *(const f32x4*)(cw + 2 * FF2 + FF + ch), bv = *(const f32x4*)(cb + FF + ch);
                const f32x4 yg0 = bg + w0g * g0 + w1g * g_1 + w2g * g_2, yv0 = bv + w0v * v0 + w1v * v_1 + w2v * v_2;
                const f32x4 yg1 = bg + w0g * g1 + w1g * g0 + w2g * g_1, yv1 = bv + w0v * v1 + w1v * v0 + w2v * v_1;
                f32x4 o0, o1;
#pragma unroll
                for (int jj = 0; jj < 4; ++jj) { o0[jj] = silu_f(yg0[jj]) * yv0[jj]; o1[jj] = silu_f(yg1[jj]) * yv1[jj]; }
                unsigned* d0 = (unsigned*)(GB + ((size_t)(blk >> 1) * (FF / 64) + (ch >> 6)) * 16384 + (size_t)((blk & 1) * 128) * 64 + (ch & 63)); unsigned* d1 = d0 + 32;
                d0[0] = cvt_pk_bf16(o0[0], o0[1]); d0[1] = cvt_pk_bf16(o0[2], o0[3]); d1[0] = cvt_pk_bf16(o1[0], o1[1]); d1[1] = cvt_pk_bf16(o1[2], o1[3]);
            }
        }
        SEAM();
        if (SITE(10) && in_ph(ph)) REPLOOP(10) {
            KArgs ap = kargs(); const bool dry = rep + 1 < NREP(10);
            pg8::Gemm g{WSP(bf16_t, WS_G), WSP(bf16_t, WS_WDN) + (size_t)l * DM * FF, MTOK, DM, FF, FF, 0}; g.atile = 1; g.fake = (FAKE_DRY && dry) ? FAKE_DRY : 0; pg8::StaticOrder SO; SO.init(MTOK, DM, gridDim.x, blockIdx.x, WGM_DOWN);
            pg8::EpiRes E{WSP(bf16_t, WS_HB), dry ? WSP(bf16_t, WS_DUM_HB) : WSP(bf16_t, WS_HB), dry ? WSP(float, WS_DUM_SLOTS) : WSP(float, WS_SLOTS)}; E.skip = (NULL_EPI && dry) ? 1 : 0; { int sk = E.skip; asm volatile("" : "+s"(sk)); E.skip = sk; }
            if (MF32_DRY && dry) pg8::gemm_phase<pg8::EpiRes, false, true>(lds, g, SO, E); else
            pg8::gemm_phase<pg8::EpiRes, false>(lds, g, SO, E);
            REPBAR(10);
        }
        SEAM();
        if (l == 1 || l == 2) FINALIZE();
    }
    if (SITE(11) && in_ph(ph)) {
        KArgs ap = kargs(); const int tid = otid(), lane = tid & 63, wave = __builtin_amdgcn_readfirstlane(tid >> 6), G = gridDim.x, bx = blockIdx.x, gw = bx * NWAVES + wave, NGW = G * NWAVES;
        const float* SLOTS = WSP(float, WS_SLOTS); float* outp = ap->out; const float* final_norm = ap->in[14]; const bf16_t* HB = WSP(bf16_t, WS_HB);
        for (int m = gw; m < MTOK; m += NGW) {
            const float rstd = 1.0f / sqrtf(wave_sum(SLOTS[(size_t)m * 64 + lane]) * (1.0f / DM) + EPS);
            const u32x4* hr = (const u32x4*)(HB + (size_t)m * DM) + lane; float* orow = outp + (size_t)m * DM + lane * 8; const float* gr = final_norm + lane * 8;
            u32x4 hv[8];
#pragma unroll
            for (int jj = 0; jj < 8; ++jj) hv[jj] = hr[64 * jj];
#pragma unroll
            for (int jj = 0; jj < 8; ++jj) { const f32x4 g0 = *(const f32x4*)(gr + 512 * jj), g1 = *(const f32x4*)(gr + 512 * jj + 4);
                f32x4 a, b; a[0] = __uint_as_float(hv[jj].x << 16); a[1] = __uint_as_float(hv[jj].x & 0xffff0000u); a[2] = __uint_as_float(hv[jj].y << 16); a[3] = __uint_as_float(hv[jj].y & 0xffff0000u);
                b[0] = __uint_as_float(hv[jj].z << 16); b[1] = __uint_as_float(hv[jj].z & 0xffff0000u); b[2] = __uint_as_float(hv[jj].w << 16); b[3] = __uint_as_float(hv[jj].w & 0xffff0000u);
                *(f32x4*)(orow + 512 * jj) = a * rstd * g0; *(f32x4*)(orow + 512 * jj + 4) = b * rstd * g1; }
        }
    }
#undef SEAM
#undef FINALIZE
#undef WSP
}

constexpr int N_PHASES = 32;
#ifndef MK_PER_PHASE
#define MK_PER_PHASE 0
#endif

extern "C" void kernel_launch(void* const* d_in, const int* in_sizes, int n_in, void* d_out, int out_size, void* d_ws, size_t ws_size, hipStream_t stream) {
    static int grid = 0;
    if (grid == 0) {
        if (n_in != 15 || out_size != MTOK * DM || ws_size < WS_END) { fprintf(stderr, "kernel_launch: unexpected shapes (n_in %d out %d ws %zu need %zu)\n", n_in, out_size, ws_size, (size_t)WS_END); grid = -1; return; }
        int dev = 0, cus = 0, per_cu = 0;
        if (hipGetDevice(&dev) != hipSuccess || hipDeviceGetAttribute(&cus, hipDeviceAttributeMultiprocessorCount, dev) != hipSuccess) { grid = -1; return; }
        if (hipFuncSetAttribute((const void*)fwd, hipFuncAttributeMaxDynamicSharedMemorySize, LDS_BYTES) != hipSuccess) { fprintf(stderr, "kernel_launch: hipFuncSetAttribute failed\n"); grid = -1; return; }
        if (hipOccupancyMaxActiveBlocksPerMultiprocessor(&per_cu, (const void*)fwd, NTHREADS, LDS_BYTES) != hipSuccess || per_cu < 1) fprintf(stderr, "kernel_launch: occupancy query says %d\n", per_cu);
        (void)hipGetLastError();
        grid = cus;
    }
    if (grid < 0) return;
    (void)hipMemsetAsync((char*)d_ws + WS_CTL, 0, XCD_BAR_WORDS * sizeof(unsigned), stream);
    Args a{};
    for (int i = 0; i < 15; ++i) a.in[i] = (const float*)d_in[i];
    a.out = (float*)d_out; a.ws = (unsigned char*)d_ws; a.pad = 0;
#if MK_PER_PHASE
    for (int p = 0; p < N_PHASES; ++p) { a.ph_lo = p; a.ph_hi = p + 1; a.one = 0; hipLaunchKernelGGL(fwd, dim3(grid), dim3(NTHREADS), LDS_BYTES, stream, a); }
#else
    a.ph_lo = 0; a.ph_hi = N_PHASES; a.one = 1;
    hipLaunchKernelGGL(fwd, dim3(grid), dim3(NTHREADS), LDS_BYTES, stream, a);
#endif
}
```

```cpp
#include <hip/hip_runtime.h>
#include <cstdio>
#include <cstdint>

#define LAS __attribute__((address_space(3)))
typedef unsigned short bf16_t;
typedef short bf16x8 __attribute__((ext_vector_type(8)));
typedef short s16x4 __attribute__((ext_vector_type(4)));
typedef float f32x4 __attribute__((ext_vector_type(4)));
typedef float f32x16 __attribute__((ext_vector_type(16)));
typedef unsigned u32x4 __attribute__((ext_vector_type(4)));

constexpr int DM = 4096, NB = 8, SEQ = 2048, MTOK = NB * SEQ, FF = 11008, FF2 = 2 * FF, NH = 32, HD = 128;
constexpr int NKVF = 2 * DM + NH, NKVFP = 8448;
constexpr float EPS = 1e-6f;
constexpr float ATT_SCALE = 0.08838834764831845f;
constexpr int NTHREADS = 512, NWAVES = 8;

constexpr size_t al256(size_t x) { return (x + 255) & ~(size_t)255; }
constexpr size_t WS_CTL = 0, CTL_BYTES = 1u << 20;
constexpr size_t SZ_WUP = (size_t)FF2 * DM * 2, SZ_WDN = (size_t)DM * FF * 2, SZ_WSQ = (size_t)DM * DM * 2, SZ_WKVF = (size_t)NKVFP * DM * 2, SZ_WP = (size_t)DM * 1024 * 2;
constexpr size_t WS_WUP = WS_CTL + CTL_BYTES;
constexpr size_t WS_WDN = WS_WUP + 4 * SZ_WUP;
constexpr size_t WS_WQ = WS_WDN + 4 * SZ_WDN;
constexpr size_t WS_WO = WS_WQ + 2 * SZ_WSQ;
constexpr size_t WS_WKVF = WS_WO + 2 * SZ_WSQ;
constexpr size_t WS_WP = WS_WKVF + SZ_WKVF;
constexpr size_t SZ_ACT = (size_t)MTOK * DM * 2;
constexpr size_t WS_HB = WS_WP + 2 * SZ_WP;
constexpr size_t WS_X1 = WS_HB + SZ_ACT;
constexpr size_t WS_X2 = WS_X1 + SZ_ACT;
constexpr size_t WS_KB = WS_X2 + SZ_ACT;
constexpr size_t WS_VB = WS_KB + SZ_ACT;
constexpr size_t WS_FLOG = WS_VB + SZ_ACT;
constexpr size_t WS_G = WS_FLOG + SZ_ACT;
constexpr size_t WS_UH = WS_G + (size_t)MTOK * FF * 2;
constexpr size_t WS_SLOTS = WS_UH + (size_t)128 * 4 * FF2 * 4;
constexpr size_t WS_CBIAS = WS_SLOTS + (size_t)MTOK * 64 * 4;
constexpr size_t WS_RSTD = WS_CBIAS + (size_t)NB * NH * SEQ * 4;
constexpr size_t WS_END0 = WS_RSTD + (size_t)MTOK * 4;
constexpr size_t WS_DUM_H = WS_END0, WS_DUM_HB = WS_DUM_H + 2 * SZ_ACT, WS_DUM_SLOTS = WS_DUM_HB + SZ_ACT;
constexpr size_t WS_END = WS_DUM_SLOTS + (size_t)MTOK * 64 * 4;

constexpr int RING_BYTES = 131072;
constexpr int LDSCTL_OFF = 139264;
constexpr int LDS_BYTES = 147456;

__device__ __forceinline__ unsigned cvt_pk_bf16(float lo, float hi) { unsigned r; asm volatile("v_cvt_pk_bf16_f32 %0, %1, %2" : "=v"(r) : "v"(lo), "v"(hi)); return r; }
__device__ __forceinline__ u32x4 pack8u(f32x4 a, f32x4 b) { u32x4 w; w.x = cvt_pk_bf16(a[0], a[1]); w.y = cvt_pk_bf16(a[2], a[3]); w.z = cvt_pk_bf16(b[0], b[1]); w.w = cvt_pk_bf16(b[2], b[3]); return w; }
__device__ __forceinline__ float wave_sum(float v) {
#pragma unroll
    for (int o = 1; o < 64; o <<= 1) v += __shfl_xor(v, o);
    return v;
}
__device__ __forceinline__ float silu_f(float y) { return y * __builtin_amdgcn_rcpf(1.0f + __builtin_amdgcn_exp2f(-1.4426950408889634f * y)); }

#define XB_TMO      128
#define XB_XCNT(j)  (256  + 64 * (j))
#define XB_XSUB(j)  (1280 + 64 * (j))
#define XB_XGEN(j)  (2304 + 64 * (j))
#define XB_TOP      3328
#define XB_TOPGEN   3392
#define XCD_BAR_WORDS 3456
#define XB_SPIN_CAP (1u << 22)

__device__ __forceinline__ unsigned xb_ld(unsigned* p)              { return __hip_atomic_load(p, __ATOMIC_RELAXED, __HIP_MEMORY_SCOPE_AGENT); }
__device__ __forceinline__ unsigned xb_add(unsigned* p, unsigned v) { return __hip_atomic_fetch_add(p, v, __ATOMIC_RELAXED, __HIP_MEMORY_SCOPE_AGENT); }
__device__ __forceinline__ unsigned xb_xcc_id() { return (unsigned)__builtin_amdgcn_s_getreg((3 << 11) | 20) & 0xFu; }
#define XB_SPIN(cond, bar) do { unsigned _sp = 0; while (cond) { __builtin_amdgcn_s_sleep(1); \
    if ((++_sp & 255u) == 0u) { if (xb_ld(&(bar)[XB_TMO])) break; if (_sp > XB_SPIN_CAP) { atomicAdd(&(bar)[XB_TMO], 1u); break; } } } } while (0)

struct XcdBarrier { unsigned* bar; unsigned x; volatile LAS unsigned* st; };
__device__ __forceinline__ XcdBarrier xcd_barrier_post(unsigned* bar, volatile LAS unsigned* st) {
    XcdBarrier b; b.bar = bar; b.x = xb_xcc_id(); b.st = st;
    if (threadIdx.x == 0) (void)xb_add(&bar[XB_XCNT(b.x)], 1u);
    return b;
}
__device__ __forceinline__ void xcd_barrier_complete(unsigned* bar, unsigned x, unsigned& nloc, unsigned& nx) {
    const unsigned G = gridDim.x * gridDim.y * gridDim.z;
    unsigned sum, cnt, mine, sp = 0u;
    for (;;) {
        sum = 0u; cnt = 0u; mine = 0u;
#pragma unroll
        for (unsigned j = 0; j < 16; ++j) { const unsigned c = xb_ld(&bar[XB_XCNT(j)]); sum += c; cnt += (c > 0u) ? 1u : 0u; mine = (j == x) ? c : mine; }
        if (sum == G) break;
        __builtin_amdgcn_s_sleep(1);
        if ((++sp & 255u) == 0u) { if (xb_ld(&bar[XB_TMO])) break; if (sp > XB_SPIN_CAP) { atomicAdd(&bar[XB_TMO], 1u); break; } }
    }
    nloc = mine > 0u ? mine : 1u; nx = cnt > 0u ? cnt : 1u;
}
__device__ __forceinline__ void xcd_barrier(const XcdBarrier& b) {
    asm volatile("s_waitcnt vmcnt(0)" ::: "memory");
    __syncthreads();
    if (threadIdx.x == 0) {
        unsigned* bar = b.bar;
        __builtin_amdgcn_s_waitcnt(0);
        unsigned nloc = b.st[0], nx = b.st[1];
        if (nloc == 0u) { xcd_barrier_complete(bar, b.x, nloc, nx); b.st[0] = nloc; b.st[1] = nx; }
        const unsigned old = xb_add(&bar[XB_XSUB(b.x)], 1u);
        const unsigned gen = old / nloc;
        if (old + 1u == (gen + 1u) * nloc) {
            __builtin_amdgcn_fence(__ATOMIC_RELEASE, "agent");
            asm volatile("s_waitcnt vmcnt(0)" ::: "memory");
            const unsigned og = xb_add(&bar[XB_TOP], 1u);
            const unsigned tg = og / nx;
            if (og + 1u == (tg + 1u) * nx) xb_add(&bar[XB_TOPGEN], 1u);
            else XB_SPIN(xb_ld(&bar[XB_TOPGEN]) == tg, bar);
            __builtin_amdgcn_fence(__ATOMIC_ACQUIRE, "agent");
            xb_add(&bar[XB_XGEN(b.x)], 1u);
            asm volatile("s_waitcnt vmcnt(0)" ::: "memory");
        } else {
            XB_SPIN(xb_ld(&bar[XB_XGEN(b.x)]) == gen, bar);
            __builtin_amdgcn_fence(__ATOMIC_ACQUIRE, "agent");
            asm volatile("s_waitcnt vmcnt(0)" ::: "memory");
        }
    }
    __syncthreads();
}

namespace pg8 {
constexpr int BM = 256, BK = 64, HALF = 128, HTB = HALF * BK * 2, STAGE_BYTES = 8 * HTB, NXCD = 8, WGM = 4;
__host__ __device__ __forceinline__ int lds_byte(int r, int c) { const int st = (r >> 4) * 2 + (c >> 5), rr = r & 15, cc = c & 31, ob = rr * 64 + cc * 2; return st * 1024 + (ob ^ (((ob >> 9) & 1) << 5)); }
__host__ __device__ __forceinline__ void stage_rc(int b, int& R, int& C) { const int st = b / 1024, sb = b % 1024, swz = sb ^ (((sb >> 9) & 1) << 5); R = (st >> 1) * 16 + swz / 64; C = (st & 1) * 32 + (swz % 64) / 2; }
__host__ __device__ __forceinline__ int perm32(int rho) { const int n = rho >> 4, i = rho & 15; return 8 * (i >> 2) + 4 * n + (i & 3); }

struct Unit { int pm, pn, kt0, nkt, kq; };
struct Gemm { const bf16_t* A; const bf16_t* Bt; int M, N, K, lda, grouped; int fake = 0; };

struct StaticOrder {
    int nM, nN, nwg, G, c, wgm;
    int tail_split = 0, tail_pn = 0, tail_nkt = 0;
    __host__ __device__ void init(int M, int N, int G_, int c_, int wgm_ = WGM) { nM = M / BM; nN = N / BM; nwg = nM * nN; G = G_; c = c_; wgm = wgm_; }
    __host__ __device__ __forceinline__ bool next(int i, Unit& u) const {
        const long L = (long)i * G + c; const long T = L - nwg; const bool tail = L >= nwg;
        const bool ok = !tail || T < (long)nM * tail_split;
        int wgid = tail ? 0 : (int)L; { const int q = nwg / NXCD, r = nwg % NXCD, xcd = wgid % NXCD, off = wgid / NXCD; wgid = (xcd < r ? xcd * (q + 1) : r * (q + 1) + (xcd - r) * q) + off; }
        const int nig = wgm * nN, gid = wgid / nig, fm = gid * wgm, gsz = (nM - fm) < wgm ? (nM - fm) : wgm;
        const int ts = tail_split > 0 ? tail_split : 1, tq = tail ? (int)(T % ts) : -1, tp = tail ? (int)(T / ts) : 0;
        Unit r_; r_.pm = tail ? tp : fm + ((wgid % nig) % gsz); r_.pn = tail ? tail_pn : (wgid % nig) / gsz; r_.kq = tq; r_.kt0 = tail ? tq * tail_nkt : 0; r_.nkt = tail ? tail_nkt : 0;
        u = r_; return ok;
    }
};

template <class Epi, bool PERMA, bool MF32 = false>
__device__ __forceinline__ void gemm_phase(LAS unsigned char* lds, const Gemm g, const StaticOrder& S, const Epi& E) {
    int tid = threadIdx.x; asm volatile("" : "+v"(tid));
    const int wid = __builtin_amdgcn_readfirstlane(tid >> 6), lane = tid & 63, wr = wid >> 2, wc = wid & 3, fr = lane & 15, fq = lane >> 4;
    const int K = g.K, nt = K / BK, lda = g.lda;
    unsigned voffA[2], voffB[2];
#pragma unroll
    for (int i = 0; i < 2; ++i) { int R, C; stage_rc(tid * 16 + i * 8192, R, C);
        const int Rb = (R & ~31) + perm32(R & 31);
        const int Ra = PERMA ? (128 * (R >> 6) + 8 * (R & 15) + ((R >> 4) & 3)) : R;
        voffA[i] = (unsigned)(Ra * lda + C) * 2u; voffB[i] = (unsigned)(Rb * 64 + C) * 2u; }
    const size_t kstep = (size_t)(BK * 2);
    const size_t hstepA = PERMA ? (size_t)4 * lda * 2 : (size_t)HALF * lda * 2;
    const size_t hstepB = (size_t)HALF * 64 * 2, kstepB = (size_t)BM * 64 * 2;
    const size_t tstepA = (size_t)BM * lda * 2, tstepB = (size_t)BM * K * 2;
    const unsigned ldsw = (unsigned)wid * 1024u;
    const int aoff = lds_byte(wr * 64 + fr, fq * 8), boff = lds_byte(wc * 32 + fr, fq * 8);
#define PG8_SA(b, h) (((b) * 2 + (h)) * HTB)
#define PG8_SB(b, h) ((4 + (b) * 2 + (h)) * HTB)
#define PG8_STAGE(bufoff, gbase, voff) do { _Pragma("unroll") for (int _i = 0; _i < 2; ++_i) \
        __builtin_amdgcn_global_load_lds((const unsigned*)((const char*)(gbase) + (voff)[_i]), (LAS unsigned*)(lds + (bufoff) + ldsw + _i * 8192), 16, 0, 0); } while (0)
#define PG8_LDA(dst, b, h) do { _Pragma("unroll") for (int m = 0; m < 4; ++m) _Pragma("unroll") for (int k = 0; k < 2; ++k) dst[m][k] = *(const LAS bf16x8*)(lds + PG8_SA(b, h) + aoff + m * 2048 + k * 1024); } while (0)
#define PG8_LDB(dst, b, h) do { _Pragma("unroll") for (int n = 0; n < 2; ++n) _Pragma("unroll") for (int k = 0; k < 2; ++k) dst[n][k] = *(const LAS bf16x8*)(lds + PG8_SB(b, h) + boff + n * 2048 + k * 1024); } while (0)
#define PG8_MMA(ai, bj, At, Bt) do { __builtin_amdgcn_s_setprio(1); if constexpr (MF32) { _Pragma("unroll") for (int blk = 0; blk < 2; ++blk) _Pragma("unroll") for (int kk = 0; kk < 4; ++kk) \
        acc32[ai][bj][blk] = __builtin_amdgcn_mfma_f32_32x32x16_bf16(Bt[kk & 1][kk >> 1], At[2 * blk + (kk & 1)][kk >> 1], acc32[ai][bj][blk], 0, 0, 0); } else { \
        _Pragma("unroll") for (int m = 0; m < 4; ++m) _Pragma("unroll") for (int n = 0; n < 2; ++n) _Pragma("unroll") for (int k = 0; k < 2; ++k) \
        acc[ai][bj][m][n] = __builtin_amdgcn_mfma_f32_16x16x32_bf16(Bt[n][k], At[m][k], acc[ai][bj][m][n], 0, 0, 0); } __builtin_amdgcn_s_setprio(0); } while (0)
#define PG8_WAIT_V(n) asm volatile("s_waitcnt vmcnt(" #n ")" ::: "memory")
#define PG8_WAIT_L(n) asm volatile("s_waitcnt lgkmcnt(" #n ")" ::: "memory")
#define PG8_BAR __builtin_amdgcn_s_barrier()
#define PG8_SCHED __builtin_amdgcn_sched_barrier(0)
    Unit cur, nxt; int ui = 0;
    if (!S.next(0, cur)) return;
    f32x4 acc[2][2][4][2];
#pragma unroll
    for (int a = 0; a < 2; ++a)
#pragma unroll
        for (int b = 0; b < 2; ++b)
#pragma unroll
            for (int m = 0; m < 4; ++m)
#pragma unroll
                for (int n = 0; n < 2; ++n) acc[a][b][m][n] = (f32x4){0.f, 0.f, 0.f, 0.f};
    f32x16 acc32[2][2][2] = {};
    bf16x8 At[4][2], B0[2][2], B1[2][2];
#define PG8_ABASE(u) ((const char*)g.A + (size_t)((g.fake & 1) ? 0 : (u).pm) * tstepA + (g.grouped ? (size_t)((u).pn >> 2) * K * 2 : (size_t)0))
#define PG8_BBASE(u) ((const char*)g.Bt + (size_t)((g.fake & 2) ? 0 : (u).pn) * tstepB)
    const char* cA = PG8_ABASE(cur) + (size_t)cur.kt0 * kstep; const char* cB = PG8_BBASE(cur) + (size_t)cur.kt0 * kstepB; int cnt = cur.nkt ? cur.nkt : nt;
    PG8_STAGE(PG8_SB(0, 0), cB, voffB); PG8_STAGE(PG8_SA(0, 0), cA, voffA); PG8_STAGE(PG8_SB(0, 1), cB + hstepB, voffB); PG8_STAGE(PG8_SA(0, 1), cA + hstepA, voffA);
    if (wr == 1) PG8_BAR;
    PG8_WAIT_V(4); PG8_BAR;
    PG8_STAGE(PG8_SB(1, 0), cB + kstepB, voffB); PG8_STAGE(PG8_SA(1, 0), cA + kstep, voffA); PG8_STAGE(PG8_SB(1, 1), cB + hstepB + kstepB, voffB);
    PG8_WAIT_V(6); PG8_BAR;
    for (;;) {
        const bool has_next = S.next(ui + 1, nxt);
        const char* nA = has_next ? PG8_ABASE(nxt) + (size_t)nxt.kt0 * kstep : cA; const char* nB = has_next ? PG8_BBASE(nxt) + (size_t)nxt.kt0 * kstepB : cB;
        for (int t = 0; t < cnt; t += 2) {
            const bool last = (t == cnt - 2);
            const char* a1 = cA + (size_t)(t + 1) * kstep;
            const char* a2 = last ? nA : cA + (size_t)(t + 2) * kstep; const char* b2 = last ? nB : cB + (size_t)(t + 2) * kstepB;
            const char* a3 = a2 + kstep; const char* b3 = b2 + kstepB;
            PG8_LDB(B0, 0, 0); PG8_SCHED; PG8_LDA(At, 0, 0); PG8_STAGE(PG8_SA(1, 1), a1 + hstepA, voffA);
            PG8_WAIT_L(8); PG8_BAR; PG8_WAIT_L(0); PG8_MMA(0, 0, At, B0); PG8_BAR; PG8_SCHED;
            PG8_LDB(B1, 0, 1); PG8_STAGE(PG8_SB(0, 0), b2, voffB);
            PG8_BAR; PG8_WAIT_L(0); PG8_MMA(0, 1, At, B1); PG8_BAR;
            PG8_LDA(At, 0, 1); PG8_STAGE(PG8_SA(0, 0), a2, voffA);
            PG8_BAR; PG8_WAIT_L(0); PG8_MMA(1, 0, At, B0); PG8_BAR; PG8_SCHED;
            PG8_STAGE(PG8_SB(0, 1), b2 + hstepB, voffB);
            PG8_WAIT_V(6); PG8_BAR; PG8_MMA(1, 1, At, B1); PG8_BAR;
            PG8_LDB(B0, 1, 0); PG8_SCHED; PG8_LDA(At, 1, 0); PG8_STAGE(PG8_SA(0, 1), a2 + hstepA, voffA);
            PG8_WAIT_L(8); PG8_BAR; PG8_WAIT_L(0); PG8_MMA(0, 0, At, B0); PG8_BAR; PG8_SCHED;
            PG8_LDB(B1, 1, 1); PG8_STAGE(PG8_SB(1, 0), b3, voffB);
            PG8_BAR; PG8_WAIT_L(0); PG8_MMA(0, 1, At, B1); PG8_BAR;
            PG8_LDA(At, 1, 1); PG8_STAGE(PG8_SA(1, 0), a3, voffA);
            PG8_BAR; PG8_WAIT_L(0); PG8_MMA(1, 0, At, B0); PG8_BAR; PG8_SCHED;
            PG8_STAGE(PG8_SB(1, 1), b3 + hstepB, voffB);
            PG8_WAIT_V(6); PG8_BAR; PG8_MMA(1, 1, At, B1); PG8_BAR;
        }
        if constexpr (MF32) { if (!E.skip) { _Pragma("unroll") for (int q = 0; q < 8; ++q) *(f32x16*)((float*)E.hout + (size_t)(cur.pm * 8 + q) * 1024 + lane * 16) = acc32[q >> 2][(q >> 1) & 1][q & 1]; }
            _Pragma("unroll") for (int q = 0; q < 8; ++q) acc32[q >> 2][(q >> 1) & 1][q & 1] = f32x16{}; }
        else E(acc, cur, wr, wc, fr, fq);
        if (!has_next) break;
#pragma unroll
        for (int a = 0; a < 2; ++a)
#pragma unroll
            for (int b = 0; b < 2; ++b)
#pragma unroll
                for (int m = 0; m < 4; ++m)
#pragma unroll
                    for (int n = 0; n < 2; ++n) acc[a][b][m][n] = (f32x4){0.f, 0.f, 0.f, 0.f};
        cur = nxt; cA = nA; cB = nB; cnt = cur.nkt ? cur.nkt : nt; ++ui;
    }
    PG8_WAIT_V(0);
    if (wr == 0) PG8_BAR;
    PG8_BAR;
#undef PG8_ABASE
#undef PG8_BBASE
#undef PG8_SA
#undef PG8_SB
#undef PG8_STAGE
#undef PG8_LDA
#undef PG8_LDB
#undef PG8_MMA
#undef PG8_WAIT_V
#undef PG8_WAIT_L
#undef PG8_BAR
#undef PG8_SCHED
}

struct EpiQ {
    bf16_t* O; const float* rstd;
    __device__ __forceinline__ void operator()(const f32x4 (&acc)[2][2][4][2], const Unit& u, int wr, int wc, int fr, int fq) const {
        const int col0 = u.pn * BM + wc * 32 + 8 * fq, row0 = u.pm * BM + wr * 64 + fr;
        float rs[2][4];
#pragma unroll
        for (int ai = 0; ai < 2; ++ai)
#pragma unroll
            for (int m = 0; m < 4; ++m) rs[ai][m] = rstd[row0 + ai * HALF + m * 16];
#pragma unroll
        for (int ai = 0; ai < 2; ++ai)
#pragma unroll
            for (int m = 0; m < 4; ++m) { bf16_t* rowp = O + (size_t)(row0 + ai * HALF + m * 16) * DM + col0;
#pragma unroll
                for (int bj = 0; bj < 2; ++bj) *(u32x4*)(rowp + bj * HALF) = pack8u(acc[ai][bj][m][0] * rs[ai][m], acc[ai][bj][m][1] * rs[ai][m]); }
    }
};
struct EpiKVF {
    bf16_t* KVF; const float* rstd; float* FP;
    __device__ __forceinline__ void operator()(const f32x4 (&acc)[2][2][4][2], const Unit& u, int wr, int wc, int fr, int fq) const {
        if (u.kq >= 0) {
            if (wc == 0) {
#pragma unroll
                for (int ai = 0; ai < 2; ++ai)
#pragma unroll
                    for (int m = 0; m < 4; ++m) { float* p = FP + ((size_t)u.kq * MTOK + (u.pm * BM + ai * HALF + wr * 64 + m * 16 + fr)) * 32 + 8 * fq; *(f32x4*)p = acc[ai][0][m][0]; *(f32x4*)(p + 4) = acc[ai][0][m][1]; } }
            return; }
        bf16_t* base = KVF + (size_t)(u.pn >> 4) * ((size_t)MTOK * DM) + (u.pn & 15) * BM + wc * 32 + 8 * fq; const int row0 = u.pm * BM + wr * 64 + fr;
        float rs[2][4];
#pragma unroll
        for (int ai = 0; ai < 2; ++ai)
#pragma unroll
            for (int m = 0; m < 4; ++m) rs[ai][m] = rstd[row0 + ai * HALF + m * 16];
#pragma unroll
        for (int ai = 0; ai < 2; ++ai)
#pragma unroll
            for (int m = 0; m < 4; ++m) { bf16_t* rowp = base + (size_t)(row0 + ai * HALF + m * 16) * DM;
#pragma unroll
                for (int bj = 0; bj < 2; ++bj) *(u32x4*)(rowp + bj * HALF) = pack8u(acc[ai][bj][m][0] * rs[ai][m], acc[ai][bj][m][1] * rs[ai][m]); }
    }
};
__device__ __forceinline__ f32x4 bf_lo4(u32x4 w) { f32x4 r; r[0] = __uint_as_float(w.x << 16); r[1] = __uint_as_float(w.x & 0xffff0000u); r[2] = __uint_as_float(w.y << 16); r[3] = __uint_as_float(w.y & 0xffff0000u); return r; }
__device__ __forceinline__ f32x4 bf_hi4(u32x4 w) { f32x4 r; r[0] = __uint_as_float(w.z << 16); r[1] = __uint_as_float(w.z & 0xffff0000u); r[2] = __uint_as_float(w.w << 16); r[3] = __uint_as_float(w.w & 0xffff0000u); return r; }
struct EpiRes {
    const bf16_t* hin; bf16_t* hout; float* slots; int skip = 0;
    __device__ __forceinline__ void operator()(const f32x4 (&acc)[2][2][4][2], const Unit& u, int wr, int wc, int fr, int fq) const {
        if (skip) return;
        const int col0 = u.pn * BM + wc * 32 + 8 * fq, row0 = u.pm * BM + wr * 64 + fr;
        u32x4 hv[2][2][2];
#define ER_LOAD(q, buf) do { _Pragma("unroll") for (int mi = 0; mi < 2; ++mi) { const size_t off = (size_t)(row0 + ((q) >> 1) * HALF + (((q) & 1) * 2 + mi) * 16) * DM + col0; \
            _Pragma("unroll") for (int bj = 0; bj < 2; ++bj) hv[buf][mi][bj] = *(const u32x4*)(hin + off + bj * HALF); } \
            asm volatile("" ::: "memory"); } while (0)
#define ER_PROC(q, buf) do { _Pragma("unroll") for (int mi = 0; mi < 2; ++mi) { const int ai = (q) >> 1, m = ((q) & 1) * 2 + mi, row = row0 + ai * HALF + m * 16; const size_t off = (size_t)row * DM + col0; float ss = 0.f; \
            _Pragma("unroll") for (int bj = 0; bj < 2; ++bj) { const f32x4 o0 = bf_lo4(hv[buf][mi][bj]) + acc[ai][bj][m][0], o1 = bf_hi4(hv[buf][mi][bj]) + acc[ai][bj][m][1]; \
                *(u32x4*)(hout + off + bj * HALF) = pack8u(o0, o1); \
                ss += ((o0[0] * o0[0] + o0[1] * o0[1]) + (o0[2] * o0[2] + o0[3] * o0[3])) + ((o1[0] * o1[0] + o1[1] * o1[1]) + (o1[2] * o1[2] + o1[3] * o1[3])); } \
            ss += __shfl_xor(ss, 16); ss += __shfl_xor(ss, 32); if (fq == 0) slots[(size_t)row * 64 + u.pn * 4 + wc] = ss; } \
            asm volatile("" ::: "memory"); } while (0)
        ER_LOAD(0, 0); ER_LOAD(1, 1); ER_PROC(0, 0); ER_LOAD(2, 0); ER_PROC(1, 1); ER_LOAD(3, 1); ER_PROC(2, 0); ER_PROC(3, 1);
#undef ER_LOAD
#undef ER_PROC
    }
};
struct EpiUp {
    bf16_t* G; float* UH; const float* rstd; const float* cw; const float* cb; int skip = 0;
    __device__ __forceinline__ void operator()(f32x4 (&acc)[2][2][4][2], const Unit& u, int wr, int wc, int fr, int fq) const {
        if (skip) return;
        const int rowbase = u.pm * BM + wr * HALF + fr * 8, ch0 = u.pn * HALF + wc * 32 + 8 * fq, blk = u.pm * 2 + wr;
        const f32x4 rsa = *(const f32x4*)(rstd + rowbase), rsb = *(const f32x4*)(rstd + rowbase + 4);
#pragma unroll
        for (int rr = 0; rr < 8; ++rr) { const float rs = rr < 4 ? rsa[rr & 3] : rsb[rr & 3];
#pragma unroll
            for (int bj = 0; bj < 2; ++bj)
#pragma unroll
                for (int n = 0; n < 2; ++n) acc[rr >> 2][bj][rr & 3][n] *= rs; }
        unsigned keep[8][2];
#pragma unroll
        for (int n = 0; n < 2; ++n) {
            const int ch = ch0 + 4 * n;
#define UG(rr) acc[(rr) >> 2][0][(rr) & 3][n]
#define UV(rr) acc[(rr) >> 2][1][(rr) & 3][n]
            f32x4 pg1, pg2, pv1, pv2;
#pragma unroll
            for (int j = 0; j < 4; ++j) { pg1[j] = __shfl_up(UG(7)[j], 1, 16); pg2[j] = __shfl_up(UG(6)[j], 1, 16); pv1[j] = __shfl_up(UV(7)[j], 1, 16); pv2[j] = __shfl_up(UV(6)[j], 1, 16); }
            if (fr == 0) { pg1 = (f32x4){0.f, 0.f, 0.f, 0.f}; pg2 = pg1; pv1 = pg1; pv2 = pg1; }
            if (fr == 0) { float* p = UH + ((size_t)(blk * 4 + 0) * 2) * FF + ch; *(f32x4*)p = UG(0); *(f32x4*)(p + FF) = UV(0); *(f32x4*)(p + 2 * FF) = UG(1); *(f32x4*)(p + 3 * FF) = UV(1); }
            if (fr == 15) { float* p = UH + ((size_t)(blk * 4 + 2) * 2) * FF + ch; *(f32x4*)p = UG(6); *(f32x4*)(p + FF) = UV(6); *(f32x4*)(p + 2 * FF) = UG(7); *(f32x4*)(p + 3 * FF) = UV(7); }
            const f32x4 w0g = *(const f32x4*)(cw + ch), w1g = *(const f32x4*)(cw + FF2 + ch), w2g = *(const f32x4*)(cw + 2 * FF2 + ch), bg = *(const f32x4*)(cb + ch);
            const f32x4 w0v = *(const f32x4*)(cw + FF + ch), w1v = *(const f32x4*)(cw + FF2 + FF + ch), w2v = *(const f32x4*)(cw + 2 * FF2 + FF + ch), bv = *(const f32x4*)(cb + FF + ch);
#pragma unroll
            for (int rr = 7; rr >= 0; --rr) {
                const f32x4 g1 = rr >= 1 ? UG(rr >= 1 ? rr - 1 : 0) : pg1, g2 = rr >= 2 ? UG(rr >= 2 ? rr - 2 : 0) : (rr == 1 ? pg1 : pg2);
                const f32x4 v1 = rr >= 1 ? UV(rr >= 1 ? rr - 1 : 0) : pv1, v2 = rr >= 2 ? UV(rr >= 2 ? rr - 2 : 0) : (rr == 1 ? pv1 : pv2);
                const f32x4 yg = bg + w0g * UG(rr) + w1g * g1 + w2g * g2, yv = bv + w0v * UV(rr) + w1v * v1 + w2v * v2;
                typedef unsigned u32x2 __attribute__((ext_vector_type(2)));
                u32x2 w; w.x = cvt_pk_bf16(silu_f(yg[0]) * yv[0], silu_f(yg[1]) * yv[1]); w.y = cvt_pk_bf16(silu_f(yg[2]) * yv[2], silu_f(yg[3]) * yv[3]);
                if (n == 0) { keep[rr][0] = w.x; keep[rr][1] = w.y; }
                else { u32x4 w4; w4.x = keep[rr][0]; w4.y = keep[rr][1]; w4.z = w.x; w4.w = w.y; *(u32x4*)(G + (size_t)(rowbase + rr) * FF + ch0) = w4; }
            }
#undef UG
#undef UV
        }
    }
};
}

namespace fa {
constexpr int D = 128, LD = DM, NW = 8, QBLK = 32, KVBLK = 64, QB = NW * QBLK;
constexpr int SHM_V = KVBLK * D * 2, SHM_K = KVBLK * D * 2;
constexpr int LDS_WS = 2 * SHM_V + 2 * SHM_K, LDS_CB = LDS_WS + NW * 64 * 4, ATT_LDS_BYTES = LDS_CB + 2 * 64 * 4;
constexpr float THR = 16.f, SCALE = ATT_SCALE;
#define KSWZ(row, colB) ((row) * 256 + ((colB) ^ (((row) & 7) << 4)))
#define SBAR() __builtin_amdgcn_sched_barrier(0)
__device__ __forceinline__ int v_st(int k, int c) { const int kk = (k & ~0xC) | ((k & 4) << 1) | ((k & 8) >> 1); return ((kk >> 3) * 4 + (c >> 5)) * 512 + ((kk & 7) * 32 + (c & 31)) * 2; }
__device__ __forceinline__ int v_rd_base(int lane) { return ((lane & 3) << 3) | (((lane >> 2) & 3) << 6) | (((lane >> 4) & 1) << 5) | (((lane >> 5) & 1) << 8); }
constexpr int v_rd_off(int d0, int ks, int half) { return d0 * 512 + ks * 4096 + half * 2048; }
__device__ __forceinline__ int crow(int r, int hi) { return (r & 3) + 8 * (r >> 2) + 4 * hi; }
__device__ __forceinline__ bf16x8 load8(const bf16_t* p) { return *reinterpret_cast<const bf16x8*>(p); }
__device__ __forceinline__ void mask_tile(f32x16& p0, f32x16& p1, int dq, unsigned W) {
    const float NEG = -__builtin_inff();
#pragma unroll
    for (int r = 0; r < 16; ++r) {
        const int c = (r & 3) + 8 * (r >> 2);
        if ((unsigned)(dq - c) >= W) p0[r] = NEG;
        if ((unsigned)(dq - c - 32) >= W) p1[r] = NEG;
    }
}
__device__ __forceinline__ void partialSM(f32x16& p0, f32x16& p1, float& m_reg, float& mn, float& alpha) {
    float pmax = p0[0]; for (int r = 1; r < 16; ++r) pmax = fmaxf(pmax, p0[r]); for (int r = 0; r < 16; ++r) pmax = fmaxf(pmax, p1[r]);
    { auto rr = __builtin_amdgcn_permlane32_swap(__float_as_uint(pmax), __float_as_uint(pmax), false, false);
      pmax = fmaxf(__uint_as_float(rr[0]), __uint_as_float(rr[1])); }
    constexpr float C2 = 1.4426950408889634f * SCALE;
    if (__builtin_expect(__all((pmax - m_reg) * SCALE <= THR), 1)) { mn = m_reg; alpha = 1.f; }
    else { mn = fmaxf(m_reg, pmax); alpha = __builtin_amdgcn_exp2f((m_reg - mn) * C2); m_reg = mn; }
    const float mnL = -mn * C2;
    for (int r = 0; r < 16; ++r) p0[r] = fmaf(p0[r], C2, mnL); for (int r = 0; r < 16; ++r) p1[r] = fmaf(p1[r], C2, mnL);
    for (int r = 0; r < 16; ++r) p0[r] = __builtin_amdgcn_exp2f(p0[r]);
}
__device__ __forceinline__ void finishSM(f32x16& p0, f32x16& p1, float alpha, float& l_reg, bf16x8& pa0, bf16x8& pa1, bf16x8& pa2, bf16x8& pa3) {
    for (int r = 0; r < 16; ++r) p1[r] = __builtin_amdgcn_exp2f(p1[r]);
    float ps = 0; for (int r = 0; r < 16; ++r) ps += p0[r]; for (int r = 0; r < 16; ++r) ps += p1[r];
    { auto rr = __builtin_amdgcn_permlane32_swap(__float_as_uint(ps), __float_as_uint(ps), false, false);
      ps = __uint_as_float(rr[0]) + __uint_as_float(rr[1]); }
    l_reg = l_reg * alpha + ps;
#define PK4(P, B_, OUT) do { unsigned a0 = cvt_pk_bf16(P[B_+0], P[B_+1]), a1 = cvt_pk_bf16(P[B_+2], P[B_+3]);                          \
        unsigned b0 = cvt_pk_bf16(P[B_+4], P[B_+5]), b1 = cvt_pk_bf16(P[B_+6], P[B_+7]);                                             \
        auto r0 = __builtin_amdgcn_permlane32_swap(a0, b0, false, false); auto r1 = __builtin_amdgcn_permlane32_swap(a1, b1, false, false); \
        u32x4 w = {r0[0], r1[0], r0[1], r1[1]}; OUT = *reinterpret_cast<bf16x8*>(&w); } while (0)
    PK4(p0, 0, pa0); PK4(p0, 8, pa1); PK4(p1, 0, pa2); PK4(p1, 8, pa3);
#undef PK4
}
template <int KB>
__device__ __forceinline__ void qkt(f32x16& p0, f32x16& p1, const char* K_lds, const float* cbl, int r32, int hi, const bf16x8* qr) {
#pragma unroll
    for (int g4 = 0; g4 < 4; ++g4) { const f32x4 c0 = *(const f32x4*)(cbl + KB * 64 + 8 * g4 + 4 * hi), c1 = *(const f32x4*)(cbl + KB * 64 + 32 + 8 * g4 + 4 * hi);
#pragma unroll
        for (int j = 0; j < 4; ++j) { p0[4 * g4 + j] = c0[j]; p1[4 * g4 + j] = c1[j]; } }
    const char* kb[4];
#pragma unroll
    for (int dd = 0; dd < 4; ++dd) kb[dd] = K_lds + KB * SHM_K + KSWZ(r32, (dd * 16 + hi * 8) * 2);
#pragma unroll
    for (int d0 = 0; d0 < 8; ++d0) { const char* a = kb[d0 & 3] + (d0 >> 2) * 128;
        bf16x8 b0 = *reinterpret_cast<const bf16x8*>(a);
        bf16x8 b1 = *reinterpret_cast<const bf16x8*>(a + 32 * 256);
        p0 = __builtin_amdgcn_mfma_f32_32x32x16_bf16(b0, qr[d0], p0, 0, 0, 0);
        p1 = __builtin_amdgcn_mfma_f32_32x32x16_bf16(b1, qr[d0], p1, 0, 0, 0); }
}
template <int VB>
__device__ __forceinline__ void pv_tile(f32x16* o, int vb0, bf16x8 pa0, bf16x8 pa1, bf16x8 pa2, bf16x8 pa3) {
#define TRRD(dst, off) asm volatile("ds_read_b64_tr_b16 %0, %1 offset:%2" : "=&v"(dst) : "v"(vb0), "i"(off) : "memory")
#define PV_D0(d0) do { s16x4 l0, l1, l2, l3, h0, h1, h2, h3; constexpr int b_ = VB * SHM_V + v_rd_off(d0, 0, 0); \
        TRRD(l0, b_); TRRD(h0, b_ + 2048); TRRD(l1, b_ + 4096); TRRD(h1, b_ + 6144); TRRD(l2, b_ + 8192); TRRD(h2, b_ + 10240); TRRD(l3, b_ + 12288); TRRD(h3, b_ + 14336); \
        asm volatile("s_waitcnt lgkmcnt(0)" ::: "memory"); SBAR();   \
        o[d0] = __builtin_amdgcn_mfma_f32_32x32x16_bf16(pa0, (bf16x8){l0[0], l0[1], l0[2], l0[3], h0[0], h0[1], h0[2], h0[3]}, o[d0], 0, 0, 0);   \
        o[d0] = __builtin_amdgcn_mfma_f32_32x32x16_bf16(pa1, (bf16x8){l1[0], l1[1], l1[2], l1[3], h1[0], h1[1], h1[2], h1[3]}, o[d0], 0, 0, 0);   \
        o[d0] = __builtin_amdgcn_mfma_f32_32x32x16_bf16(pa2, (bf16x8){l2[0], l2[1], l2[2], l2[3], h2[0], h2[1], h2[2], h2[3]}, o[d0], 0, 0, 0);   \
        o[d0] = __builtin_amdgcn_mfma_f32_32x32x16_bf16(pa3, (bf16x8){l3[0], l3[1], l3[2], l3[3], h3[0], h3[1], h3[2], h3[3]}, o[d0], 0, 0, 0); } while (0)
    PV_D0(0); PV_D0(1); PV_D0(2); PV_D0(3);
#undef PV_D0
#undef TRRD
}
struct BlockRef { const bf16_t* Q; const bf16_t* K; const bf16_t* V; const float* CB; bf16_t* O; int P0; };
struct Seam { bf16x8 qr[8]; bf16x8 st_v0, st_v1, st_k0, st_k1; };
#define ROW(p, k0, rr) ((p) + (size_t)((k0) + (rr)) * LD + sc)
#define VMW() asm volatile("s_waitcnt vmcnt(0)" ::: "memory")
#define VMWN(n) asm volatile("s_waitcnt vmcnt(%0)" :: "i"(n) : "memory")
#define SLOAD_H(Kp, Vp, Cp, k0, bf) do { if (wid == 0) __builtin_amdgcn_global_load_lds((const unsigned*)((Cp) + (k0) + lane), (LAS unsigned*)(cbd + (bf) * 64), 4, 0, 0); \
                         S.st_v0 = load8(ROW(Vp, k0, sr)); S.st_v1 = load8(ROW(Vp, k0, 32 + sr));              \
                         S.st_k0 = load8(ROW(Kp, k0, sr)); S.st_k1 = load8(ROW(Kp, k0, 32 + sr)); } while (0)
#define SWRITE_HK(bf) do { *(bf16x8*)(K_lds + (bf) * SHM_K + kws) = S.st_k0; *(bf16x8*)(K_lds + (bf) * SHM_K + kws + 32 * 256) = S.st_k1; } while (0)
#define SWRITE_HV(bf) do { *(bf16x8*)(V_lds + (bf) * SHM_V + vst0) = S.st_v0; *(bf16x8*)(V_lds + (bf) * SHM_V + vst1) = S.st_v1; } while (0)
#define SWRITE_H(bf) do { SWRITE_HV(bf); SWRITE_HK(bf); } while (0)
__device__ __forceinline__ void prime(const BlockRef& cur, char* lds, LAS float* cbd, Seam& S) {
    int tid = threadIdx.x; asm volatile("" : "+v"(tid));
    const int wid = __builtin_amdgcn_readfirstlane(tid >> 6), lane = tid & 63, r32 = lane & 31, hi = lane >> 5;
    const int sr = tid >> 4, sc = (tid & 15) * 8, kws = KSWZ(sr, sc * 2); char* K_lds = lds + 2 * SHM_V;
    for (int d0 = 0; d0 < 8; ++d0) S.qr[d0] = load8(cur.Q + (size_t)(wid * QBLK + r32) * LD + d0 * 16 + hi * 8);
    SLOAD_H(cur.K, cur.V, cur.CB, ((cur.P0 + QB - 1) / KVBLK) * KVBLK, 0); VMW(); SWRITE_HK(0);
    __syncthreads();
}
__device__ __forceinline__ void block(const BlockRef& cur, const BlockRef& nxt, char* lds, LAS float* cbd, Seam& S) {
    int tid = threadIdx.x; asm volatile("" : "+v"(tid));
    const int wid = __builtin_amdgcn_readfirstlane(tid >> 6), lane = tid & 63, r32 = lane & 31, hi = lane >> 5;
    constexpr int W = SEQ;
    const int NT = (cur.P0 + QB - 1) / KVBLK + 1;
    const int kbn = ((nxt.P0 + QB - 1) / KVBLK) * KVBLK;
    const int qlo = cur.P0 + wid * QBLK, qm = qlo + r32 - 4 * hi;
    char* V_lds = lds; char* K_lds = lds + 2 * SHM_V; float* cbl = (float*)(lds + LDS_CB);
    float* ws = (float*)(lds + LDS_WS) + wid * 64; float* li_l = ws, * al_l = ws + 32;
    float m_reg = -1e30f, l_reg = 0; f32x16 o[4] = {};
    const int sr = tid >> 4, sc = (tid & 15) * 8, vst0 = v_st(sr, sc), vst1 = v_st(32 + sr, sc), kws = KSWZ(sr, sc * 2);
    const int vb0 = (int)(uintptr_t)V_lds + v_rd_base(lane);
    const bf16_t* Kh = cur.K; const bf16_t* Vh = cur.V; const float* Ch = cur.CB;
#define RESC(a) do { if (__any((a) < 1.f)) { if (hi == 0) al_l[r32] = (a); asm volatile("s_waitcnt lgkmcnt(0)" ::: "memory");              \
                     for (int d_ = 0; d_ < 4; ++d_) for (int r = 0; r < 16; ++r) o[d_][r] *= al_l[crow(r, hi)]; } } while (0)
#define KBASE(t) ((NT - 1 - (t)) * KVBLK)
#define MASKT(P0_, P1_, t) do { const int kb_ = KBASE(t); if (kb_ + KVBLK - 1 > qlo) mask_tile(P0_, P1_, qm - kb_, (unsigned)W); } while (0)
    constexpr int NQL = 8;
#define SEAM_K0() do { VMWN(NQL); SWRITE_HK(0); SBAR(); } while (0)
    f32x16 pA0, pA1, pB0, pB1; float mnA, mnB, alA, alB; bf16x8 pa0, pa1, pa2, pa3;
    SWRITE_HV(0); SBAR();
    if (NT > 1) { SLOAD_H(Kh, Vh, Ch, KBASE(1), 1); }
    SBAR(); qkt<0>(pA0, pA1, K_lds, cbl, r32, hi, S.qr);
    MASKT(pA0, pA1, 0); partialSM(pA0, pA1, m_reg, mnA, alA);
    if (NT > 1) { VMW(); SWRITE_H(1); }
    __syncthreads();
#define HALF_STEP(PX0, PX1, mnX, alX, PY0, PY1, alY, t, KB, VB, SB) do {                                                      \
        SBAR(); qkt<KB>(PX0, PX1, K_lds, cbl, r32, hi, S.qr);                                                                 \
        finishSM(PY0, PY1, alY, l_reg, pa0, pa1, pa2, pa3); SBAR();                                                           \
        if ((t) + 1 < NT) { SLOAD_H(Kh, Vh, Ch, KBASE((t) + 1), SB); SBAR(); }                                                    \
        pv_tile<VB>(o, vb0, pa0, pa1, pa2, pa3); MASKT(PX0, PX1, (t)); partialSM(PX0, PX1, m_reg, mnX, alX);                  \
        __syncthreads();                                                                                                      \
        if ((t) + 1 < NT) { VMW(); SWRITE_H(SB); }                                                                            \
        RESC(alX); __syncthreads(); } while (0)
    for (int t = 1; t + 1 < NT; t += 2) {
        HALF_STEP(pB0, pB1, mnB, alB, pA0, pA1, alA, t, 1, 0, 0);
        HALF_STEP(pA0, pA1, mnA, alA, pB0, pB1, alB, t + 1, 0, 1, 1);
    }
    const bool even = (NT & 1) == 0;
    if (even) { SBAR(); qkt<1>(pB0, pB1, K_lds, cbl, r32, hi, S.qr); SBAR(); }
    SLOAD_H(nxt.K, nxt.V, nxt.CB, kbn, 0); SBAR();
#pragma unroll
    for (int d0 = 0; d0 < 8; ++d0) S.qr[d0] = load8(nxt.Q + (size_t)(wid * QBLK + r32) * LD + d0 * 16 + hi * 8);
    SBAR();
    finishSM(pA0, pA1, alA, l_reg, pa0, pa1, pa2, pa3); SBAR();
    pv_tile<0>(o, vb0, pa0, pa1, pa2, pa3);
    if (even) { MASKT(pB0, pB1, NT - 1); partialSM(pB0, pB1, m_reg, mnB, alB); __syncthreads(); RESC(alB);
        finishSM(pB0, pB1, alB, l_reg, pa0, pa1, pa2, pa3); SBAR(); pv_tile<1>(o, vb0, pa0, pa1, pa2, pa3); }
    SBAR(); SEAM_K0();
    if (hi == 0) li_l[r32] = l_reg; asm volatile("s_waitcnt lgkmcnt(0)" ::: "memory");
    float rli[16];
#pragma unroll
    for (int r = 0; r < 16; ++r) rli[r] = __builtin_amdgcn_rcpf(li_l[crow(r, hi)]);
    bf16_t* Ow = cur.O + (size_t)(wid * QBLK) * LD;
#pragma unroll
    for (int r = 0; r < 16; ++r) { const int orow = crow(r, hi);
#pragma unroll
        for (int d0 = 0; d0 < 4; ++d0) { const float v = o[d0][r] * rli[r];
            const float vn = __shfl_xor(v, 1);
            if ((r32 & 1) == 0) *(unsigned*)(Ow + (size_t)orow * LD + d0 * 32 + r32) = cvt_pk_bf16(v, vn); } }
    __syncthreads();
#undef RESC
#undef KBASE
#undef MASKT
#undef SEAM_K0
#undef HALF_STEP
}
#undef ROW
#undef VMW
#undef VMWN
#undef SLOAD_H
#undef SWRITE_HK
#undef SWRITE_HV
#undef SWRITE_H
__device__ __forceinline__ BlockRef make_ref(int L, int pass, const bf16_t* Q, const bf16_t* K, const bf16_t* V, const float* CB, bf16_t* O) {
    const int bh = L >> 2, x = L & 3, qb = pass ? 7 - x : x, b = bh / NH, h = bh % NH;
    BlockRef r; const size_t rowoff = ((size_t)b * SEQ) * LD + (size_t)h * D;
    r.Q = Q + rowoff + (size_t)qb * QB * LD; r.O = O + rowoff + (size_t)qb * QB * LD; r.K = K + rowoff; r.V = V + rowoff; r.CB = CB + (size_t)bh * SEQ; r.P0 = qb * QB;
    return r;
}
__device__ __forceinline__ void attn_phase(char* lds, LAS float* cbd, const bf16_t* Q, const bf16_t* K, const bf16_t* V, const float* CB, bf16_t* O) {
    const int total = NB * NH * 4, stride = gridDim.x;
    int L = blockIdx.x; if (L >= total) return;
    int pass = 0;
    BlockRef cur = make_ref(L, 0, Q, K, V, CB, O);
    Seam S;
    prime(cur, lds, cbd, S);
    for (;;) {
        const bool more_pass = pass == 0, more_item = L + stride < total, last = !more_pass && !more_item;
        int passn = pass + 1, Ln = L;
        if (!more_pass) { passn = 0; Ln = more_item ? L + stride : L; }
        const BlockRef nxt = last ? cur : make_ref(Ln, passn, Q, K, V, CB, O);
        block(cur, nxt, lds, cbd, S);
        if (last) break;
        cur = nxt; pass = passn; L = Ln;
    }
}
#undef KSWZ
#undef SBAR
}

struct Args { const float* in[15]; float* out; unsigned char* ws; int ph_lo, ph_hi, one, pad; };
typedef const __attribute__((address_space(4))) Args* KArgsT;
struct TrItem { const float* src; const float* gk; const float* gn; bf16_t* dst; int K, N, upmap, k0, n0; };
__device__ __forceinline__ TrItem tr_decode(int it, KArgsT ap) {
    constexpr int I_POOL = 8 * 16 * 16, I_KVF = 64 * 129, I_SQ = 64 * 64, I_UP = 64 * 344, I_DN = 172 * 64;
    TrItem t; int r = it;
    if (r < I_POOL) { const int mat = r >> 8, q = r & 255;
        t.src = ap->in[3] + (size_t)mat * 1024 * 1024; t.gk = nullptr; t.gn = ap->in[4] + (size_t)mat * 1024; t.dst = (bf16_t*)(ap->ws + WS_WP) + (size_t)mat * 1024 * 1024; t.K = 1024; t.N = 1024; t.upmap = 0; t.k0 = 64 * (q >> 4); t.n0 = 64 * (q & 15); return t; }
    r -= I_POOL;
    if (r < I_KVF) { t.src = ap->in[6]; t.gk = ap->in[5]; t.gn = nullptr; t.dst = (bf16_t*)(ap->ws + WS_WKVF); t.K = DM; t.N = NKVF; t.upmap = 0; t.k0 = 64 * (r / 129); t.n0 = 64 * (r % 129); return t; }
    r -= I_KVF;
    if (r < 4 * I_SQ) { const int mat = r / I_SQ, q = r % I_SQ;
        if (mat < 2) { t.src = ap->in[8] + (size_t)mat * DM * DM; t.gk = ap->in[1] + (size_t)(2 + mat) * DM; t.dst = (bf16_t*)(ap->ws + WS_WQ) + (size_t)mat * DM * DM; }
        else { t.src = ap->in[9] + (size_t)(mat - 2) * DM * DM; t.gk = nullptr; t.dst = (bf16_t*)(ap->ws + WS_WO) + (size_t)(mat - 2) * DM * DM; }
        t.gn = nullptr; t.K = DM; t.N = DM; t.upmap = 0; t.k0 = 64 * (q >> 6); t.n0 = 64 * (q & 63); return t; }
    r -= 4 * I_SQ;
    if (r < 4 * I_UP) { const int l = r / I_UP, q = r % I_UP;
        t.src = ap->in[10] + (size_t)l * DM * FF2; t.gk = ap->in[2] + (size_t)l * DM; t.gn = nullptr; t.dst = (bf16_t*)(ap->ws + WS_WUP) + (size_t)l * FF2 * DM; t.K = DM; t.N = FF2; t.upmap = 1; t.k0 = 64 * (q / 344); t.n0 = 64 * (q % 344); return t; }
    r -= 4 * I_UP;
    { const int l = r / I_DN, q = r % I_DN;
      t.src = ap->in[13] + (size_t)l * FF * DM; t.gk = nullptr; t.gn = nullptr; t.dst = (bf16_t*)(ap->ws + WS_WDN) + (size_t)l * DM * FF; t.K = FF; t.N = DM; t.upmap = 0; t.k0 = 64 * (q >> 6); t.n0 = 64 * (q & 63); return t; }
}
__device__ __forceinline__ void tr_load(const TrItem& t, float (&v)[64], int lane) {
    const bool nok = (t.n0 + lane) < t.N; const float* p = t.src + (size_t)t.k0 * t.N + t.n0 + lane;
#pragma unroll
    for (int i = 0; i < 64; ++i) v[i] = nok ? p[(size_t)i * t.N] : 0.f;
}
__device__ __forceinline__ void tr_emit(const TrItem& t, const float (&v)[64], LAS float* scr, int lane) {
    const float gnv = (t.gn && (t.n0 + lane) < t.N) ? t.gn[t.n0 + lane] : 1.f;
#pragma unroll
    for (int i = 0; i < 64; ++i) { const float gkv = t.gk ? t.gk[t.k0 + i] : 1.f; scr[i * 65 + lane] = v[i] * (gkv * gnv); }
    asm volatile("s_waitcnt lgkmcnt(0)" ::: "memory");
    const int c = lane & 7;
#pragma unroll
    for (int j = 0; j < 8; ++j) { const int n = (lane >> 3) + 8 * j; const LAS float* sp = scr + (8 * c) * 65 + n;
        u32x4 o; o.x = cvt_pk_bf16(sp[0 * 65], sp[1 * 65]); o.y = cvt_pk_bf16(sp[2 * 65], sp[3 * 65]); o.z = cvt_pk_bf16(sp[4 * 65], sp[5 * 65]); o.w = cvt_pk_bf16(sp[6 * 65], sp[7 * 65]);
        const int ng = t.n0 + n; int nd = ng;
        if (t.upmap) { const int isv = ng >= FF ? 1 : 0, ch = ng - isv * FF; nd = 256 * (ch >> 7) + 128 * isv + (ch & 127); }
        if (ng < t.N) *(u32x4*)(t.dst + ((size_t)(nd >> 8) * (t.K >> 6) + (t.k0 >> 6)) * 16384 + (nd & 255) * 64 + 8 * c) = o; }
    asm volatile("s_waitcnt lgkmcnt(0)" ::: "memory");
}

typedef KArgsT KArgs;
__device__ __forceinline__ KArgs kargs() { unsigned long long p = (unsigned long long)__builtin_amdgcn_kernarg_segment_ptr(); asm volatile("" : "+s"(p)); return (KArgs)p; }
__device__ __forceinline__ int otid() { int t = threadIdx.x; asm volatile("" : "+v"(t)); return t; }
__device__ __forceinline__ bool in_ph(int ph) { KArgs ap = kargs(); return ap->ph_lo <= ph && ph < ap->ph_hi; }
__device__ __forceinline__ void seam(int ph, LAS unsigned char* lds) {
    KArgs ap = kargs();
    if (ap->one && ph + 1 < ap->ph_hi) { XcdBarrier b; b.bar = (unsigned*)(ap->ws + WS_CTL); b.x = xb_xcc_id(); b.st = (volatile LAS unsigned*)(lds + LDSCTL_OFF); xcd_barrier(b); }
}

__device__ __forceinline__ void seam_force(LAS unsigned char* lds) {
    KArgs ap = kargs();
    if (ap->one) { XcdBarrier b; b.bar = (unsigned*)(ap->ws + WS_CTL); b.x = xb_xcc_id(); b.st = (volatile LAS unsigned*)(lds + LDSCTL_OFF); xcd_barrier(b); }
}
__global__ void __launch_bounds__(NTHREADS, 2) fwd(Args a_) {
    extern __shared__ __attribute__((aligned(16))) unsigned char lds_raw[];
    LAS unsigned char* lds = (LAS unsigned char*)lds_raw;
    { const int tid = otid(); if (tid < 64) ((LAS unsigned*)(lds + LDSCTL_OFF))[tid] = 0u; }
    __syncthreads();
    { KArgs ap = kargs(); if (ap->one) (void)xcd_barrier_post((unsigned*)(ap->ws + WS_CTL), (volatile LAS unsigned*)(lds + LDSCTL_OFF)); }
    int ph = 0;
#ifndef PH_MASK
#define PH_MASK 0xFFF
#endif
#define SITE(n) (((PH_MASK) >> (n)) & 1)
#ifndef REP_MASK
#define REP_MASK 0
#endif
#ifndef FAKE_DRY
#define FAKE_DRY 0
#endif
#ifndef NULL_EPI
#define NULL_EPI 0
#endif
#ifndef WGM_DOWN
#define WGM_DOWN 2
#endif
#ifndef MF32_DRY
#define MF32_DRY 0
#endif
#define NREP(n) ((((REP_MASK) >> (n)) & 1) ? 2 : 1)
#define REPLOOP(n) _Pragma("nounroll") for (int rep = 0; rep < NREP(n); ++rep)
#define REPBAR(n) do { if (NREP(n) > 1 && rep + 1 < NREP(n)) seam_force(lds); } while (0)
#define SEAM() do { seam(ph, lds); ++ph; } while (0)
#define WSP(T, off) ((T*)(ap->ws + (off)))
#define FINALIZE() do { if (in_ph(ph)) { KArgs ap = kargs(); const int tid = otid(); const float* SLOTS = WSP(float, WS_SLOTS); float* RSTD = WSP(float, WS_RSTD); \
        for (int i = blockIdx.x * NTHREADS + tid; i < MTOK * 8; i += gridDim.x * NTHREADS) { const f32x4* p = (const f32x4*)(SLOTS + (size_t)i * 8); const f32x4 u0 = p[0], u1 = p[1]; \
            float sq = ((u0[0] + u0[1]) + (u0[2] + u0[3])) + ((u1[0] + u1[1]) + (u1[2] + u1[3])); sq += __shfl_xor(sq, 1); sq += __shfl_xor(sq, 2); sq += __shfl_xor(sq, 4); \
            if ((i & 7) == 0) RSTD[i >> 3] = 1.0f / sqrtf(sq * (1.0f / DM) + EPS); } } SEAM(); } while (0)

    if (SITE(0) && in_ph(ph)) REPLOOP(0) {
        KArgs ap = kargs(); const int tid = otid(), lane = tid & 63, wave = __builtin_amdgcn_readfirstlane(tid >> 6), G = gridDim.x, bx = blockIdx.x, gw = bx * NWAVES + wave, NGW = G * NWAVES;
        const float* x = ap->in[0]; bf16_t* WkvfT = WSP(bf16_t, WS_WKVF); float* RSTD = WSP(float, WS_RSTD);
        LAS float* scr = (LAS float*)(lds + wave * 16640);
        constexpr int NITEMS = 8 * 16 * 16 + 64 * 129 + 4 * 64 * 64 + 4 * 64 * 344 + 4 * 172 * 64;
        { float va[64], vb[64]; int it = gw;
          if (it < NITEMS) { TrItem ta = tr_decode(it, ap); tr_load(ta, va, lane);
            for (;;) {
                const int itb = it + NGW; const bool hb_ = itb < NITEMS; TrItem tb = ta;
                if (hb_) { tb = tr_decode(itb, ap); tr_load(tb, vb, lane); }
                tr_emit(ta, va, scr, lane);
                if (!hb_) break;
                const int itc = itb + NGW; const bool hc_ = itc < NITEMS;
                if (hc_) { ta = tr_decode(itc, ap); tr_load(ta, va, lane); }
                tr_emit(tb, vb, scr, lane);
                if (!hc_) break;
                it = itc;
            } } }
        for (int i = bx * NTHREADS + tid; i < (NKVFP - NKVF) * (DM / 8); i += G * NTHREADS) { const int kt = i / ((NKVFP - NKVF) * 8), rem = i % ((NKVFP - NKVF) * 8), r = rem >> 3, c = rem & 7;
            *(u32x4*)(WkvfT + ((size_t)32 * (DM / 64) + kt) * 16384 + (32 + r) * 64 + c * 8) = (u32x4){0u, 0u, 0u, 0u}; }
        for (int m = gw; m < MTOK; m += NGW) { const f32x4* xr = (const f32x4*)(x + (size_t)m * DM) + lane; float sq = 0.f;
            typedef unsigned u32x2 __attribute__((ext_vector_type(2))); u32x2* hbr = (u32x2*)(WSP(bf16_t, WS_HB) + (size_t)m * DM) + lane;
#pragma unroll
            for (int j = 0; j < 16; ++j) { const f32x4 v = xr[64 * j]; sq += (v[0] * v[0] + v[1] * v[1]) + (v[2] * v[2] + v[3] * v[3]); u32x2 w; w.x = cvt_pk_bf16(v[0], v[1]); w.y = cvt_pk_bf16(v[2], v[3]); hbr[64 * j] = w; }
            sq = wave_sum(sq); if (lane == 0) RSTD[m] = 1.0f / sqrtf(sq * (1.0f / DM) + EPS); }
        REPBAR(0);
    }
    SEAM();


#ifdef MFMA_PROBE
    {
        const int tid = otid(); KArgs ap = kargs();
        bf16x8 pa, pb;
#pragma unroll
        for (int j = 0; j < 8; ++j) { pa[j] = (short)(0x3f80 + ((tid * 7 + j * 13) & 0x7f) + ((tid & 1) << 15)); pb[j] = (short)(0x3c00 + ((tid * 5 + j * 11) & 0x7f) + ((j & 1) << 15)); }
        f32x4 c[8];
#pragma unroll
        for (int j = 0; j < 8; ++j) c[j] = (f32x4){0.f, 0.f, 0.f, 0.f};
#pragma nounroll
        for (int i = 0; i < 25000; ++i) {
#pragma unroll
            for (int j = 0; j < 8; ++j) c[j] = __builtin_amdgcn_mfma_f32_16x16x32_bf16(pa, pb, c[j], 0, 0, 0);
        }
        float sum = 0.f;
#pragma unroll
        for (int j = 0; j < 8; ++j) sum += c[j][0] + c[j][1] + c[j][2] + c[j][3];
        if (sum == 12345.678f) WSP(float, WS_DUM_SLOTS)[tid] = sum;
    }
#endif
#pragma nounroll
    for (int l = 0; l < 4; ++l) {
        if (l < 2) {
            if (SITE(1) && in_ph(ph)) REPLOOP(1) {
                KArgs ap = kargs(); const int tid = otid(), G = gridDim.x, bx = blockIdx.x;
                const bf16_t* hin = WSP(bf16_t, WS_HB); const float* RSTD = WSP(float, WS_RSTD); const float* SLOTS = WSP(float, WS_SLOTS); bf16_t* X1 = WSP(bf16_t, WS_X1);
                LAS float* rs = (LAS float*)lds;
                const float* gn = ap->in[1] + (size_t)l * DM;
                for (int chunk = bx; chunk < MTOK / 64; chunk += G) {
                    const int r0 = chunk * 64, t0 = r0 % SEQ;
                    __syncthreads();
                    if (l == 0) { if (tid < 80) rs[tid] = (t0 - 16 + tid >= 0) ? RSTD[r0 - 16 + tid] : 0.f; }
                    else {
#pragma unroll
                        for (int pass = 0; pass < 2; ++pass) { const int i = pass * 64 + (tid >> 3), part = tid & 7;
                            float sq = 0.f; const bool ok = (i < 80) && (t0 - 16 + i >= 0);
                            if (ok) { const f32x4* p = (const f32x4*)(SLOTS + (size_t)(r0 - 16 + i) * 64 + part * 8); const f32x4 u0 = p[0], u1 = p[1]; sq = ((u0[0] + u0[1]) + (u0[2] + u0[3])) + ((u1[0] + u1[1]) + (u1[2] + u1[3])); }
                            sq += __shfl_xor(sq, 1); sq += __shfl_xor(sq, 2); sq += __shfl_xor(sq, 4);
                            if (part == 0 && i < 80) rs[i] = ok ? 1.0f / sqrtf(sq * (1.0f / DM) + EPS) : 0.f; } }
                    __syncthreads();
                    const int c0 = tid * 8, w = 2 << (tid >> 7);
                    const f32x4 g0 = *(const f32x4*)(gn + c0), g1 = *(const f32x4*)(gn + c0 + 4);
                    f32x4 s0 = {0.f, 0.f, 0.f, 0.f}, s1 = s0;
                    for (int j = 1; j < w; ++j) { if (t0 - j >= 0) { const u32x4 hw = *(const u32x4*)(hin + (size_t)(r0 - j) * DM + c0); const float r = rs[16 - j]; s0 += pg8::bf_lo4(hw) * r; s1 += pg8::bf_hi4(hw) * r; } }
                    for (int i0 = 0; i0 < 64; i0 += 4) {
                        u32x4 nw[4], ow[4];
#pragma unroll
                        for (int k = 0; k < 4; ++k) { nw[k] = *(const u32x4*)(hin + (size_t)(r0 + i0 + k) * DM + c0);
                            const int to = t0 + i0 + k - w + 1;
                            if (to >= 0) ow[k] = *(const u32x4*)(hin + (size_t)(r0 + i0 + k - w + 1) * DM + c0); else ow[k] = (u32x4){0u, 0u, 0u, 0u}; }
#pragma unroll
                        for (int k = 0; k < 4; ++k) { const int i = i0 + k; const float r = rs[16 + i];
                            const f32x4 n0 = pg8::bf_lo4(nw[k]) * r, n1 = pg8::bf_hi4(nw[k]) * r;
                            s0 += n0; s1 += n1;
                            const int t = t0 + i; const float inv = 1.0f / (float)(t + 1 < w ? t + 1 : w);
                            const f32x4 m0 = g0 * (s0 * inv - n0), m1 = g1 * (s1 * inv - n1);
                            *(u32x4*)(X1 + (size_t)(r0 + i) * DM + c0) = pack8u(m0, m1);
                            if (t - w + 1 >= 0) { const float rq = rs[16 + i - w + 1]; s0 -= pg8::bf_lo4(ow[k]) * rq; s1 -= pg8::bf_hi4(ow[k]) * rq; } }
                    }
                }
                REPBAR(1);
            }
            SEAM();
            if (SITE(2) && in_ph(ph)) REPLOOP(2) {
                KArgs ap = kargs(); const bool dry = rep + 1 < NREP(2);
                pg8::Gemm g{WSP(bf16_t, WS_X1), WSP(bf16_t, WS_WP) + (size_t)l * DM * 1024, MTOK, DM, 1024, DM, 1}; pg8::StaticOrder SO; SO.init(MTOK, DM, gridDim.x, blockIdx.x);
                pg8::EpiRes E{WSP(bf16_t, WS_HB), dry ? WSP(bf16_t, WS_DUM_HB) : WSP(bf16_t, WS_HB), dry ? WSP(float, WS_DUM_SLOTS) : WSP(float, WS_SLOTS)};
                pg8::gemm_phase<pg8::EpiRes, false>(lds, g, SO, E);
                REPBAR(2);
            }
            SEAM();
            FINALIZE();
        } else {
            if (l == 2) {
                if (SITE(3) && in_ph(ph)) REPLOOP(3) {
                    KArgs ap = kargs();
                    pg8::Gemm g{WSP(bf16_t, WS_HB), WSP(bf16_t, WS_WKVF), MTOK, NKVFP, DM, DM, 0}; pg8::StaticOrder SO; SO.init(MTOK, 2 * DM, gridDim.x, blockIdx.x);
                    SO.tail_split = 4; SO.tail_pn = 32; SO.tail_nkt = DM / 64 / 4;
                    pg8::EpiKVF E{WSP(bf16_t, WS_KB), WSP(float, WS_RSTD), WSP(float, WS_FLOG)};
                    pg8::gemm_phase<pg8::EpiKVF, false>(lds, g, SO, E);
                    REPBAR(3);
                }
                SEAM();
                if (SITE(4) && in_ph(ph)) {
                    KArgs ap = kargs(); const int tid = otid(), lane = tid & 63, wave = __builtin_amdgcn_readfirstlane(tid >> 6), G = gridDim.x, bx = blockIdx.x;
                    const float* FP = WSP(float, WS_FLOG); const float* RSTD = WSP(float, WS_RSTD); float* CBIAS = WSP(float, WS_CBIAS); const float* b_f = ap->in[7];
                    if (wave == 0) for (int seq = bx; seq < NB * NH; seq += G) {
                        const int b = seq / NH, h = seq % NH; const float bf = b_f[h];
                        float v[32]; float run = 0.f;
#pragma unroll
                        for (int i = 0; i < 32; ++i) { const size_t row = (size_t)b * SEQ + lane * 32 + i; const float z = ((FP[row * 32 + h] + FP[((size_t)MTOK + row) * 32 + h]) + (FP[((size_t)2 * MTOK + row) * 32 + h] + FP[((size_t)3 * MTOK + row) * 32 + h])) * RSTD[row] + bf; const float ls = fminf(z, 0.f) - log1pf(expf(-fabsf(z))); run += ls; v[i] = run; }
                        float incl = run;
#pragma unroll
                        for (int o = 1; o < 64; o <<= 1) { const float t = __shfl_up(incl, o); if (lane >= o) incl += t; }
                        const float excl = incl - run;
#pragma unroll
                        for (int i = 0; i < 32; i += 4) { f32x4 w; w[0] = -(v[i] + excl) * (1.0f / ATT_SCALE); w[1] = -(v[i + 1] + excl) * (1.0f / ATT_SCALE); w[2] = -(v[i + 2] + excl) * (1.0f / ATT_SCALE); w[3] = -(v[i + 3] + excl) * (1.0f / ATT_SCALE);
                            *(f32x4*)(CBIAS + (size_t)seq * SEQ + lane * 32 + i) = w; }
                    }
                }
                SEAM();
            }
            if (SITE(5) && in_ph(ph)) REPLOOP(5) {
                KArgs ap = kargs();
                pg8::Gemm g{WSP(bf16_t, WS_HB), WSP(bf16_t, WS_WQ) + (size_t)(l - 2) * DM * DM, MTOK, DM, DM, DM, 0}; pg8::StaticOrder SO; SO.init(MTOK, DM, gridDim.x, blockIdx.x);
                pg8::EpiQ E{WSP(bf16_t, WS_X1), WSP(float, WS_RSTD)};
                pg8::gemm_phase<pg8::EpiQ, false>(lds, g, SO, E);
                REPBAR(5);
            }
            SEAM();
            if (SITE(6) && in_ph(ph)) REPLOOP(6) { KArgs ap = kargs(); fa::attn_phase((char*)lds_raw, (LAS float*)(lds + fa::LDS_CB), WSP(bf16_t, WS_X1), WSP(bf16_t, WS_KB), WSP(bf16_t, WS_VB), WSP(float, WS_CBIAS), WSP(bf16_t, WS_X2)); REPBAR(6); }
            SEAM();
            if (SITE(7) && in_ph(ph)) REPLOOP(7) {
                KArgs ap = kargs(); const bool dry = rep + 1 < NREP(7);
                pg8::Gemm g{WSP(bf16_t, WS_X2), WSP(bf16_t, WS_WO) + (size_t)(l - 2) * DM * DM, MTOK, DM, DM, DM, 0}; pg8::StaticOrder SO; SO.init(MTOK, DM, gridDim.x, blockIdx.x);
                pg8::EpiRes E{WSP(bf16_t, WS_HB), dry ? WSP(bf16_t, WS_DUM_HB) : WSP(bf16_t, WS_HB), dry ? WSP(float, WS_DUM_SLOTS) : WSP(float, WS_SLOTS)};
                pg8::gemm_phase<pg8::EpiRes, false>(lds, g, SO, E);
                REPBAR(7);
            }
            SEAM();
            FINALIZE();
        }
        if (SITE(8) && in_ph(ph)) REPLOOP(8) {
            KArgs ap = kargs();
            const bool dry = rep + 1 < NREP(8);
            pg8::Gemm g{WSP(bf16_t, WS_HB), WSP(bf16_t, WS_WUP) + (size_t)l * FF2 * DM, MTOK, FF2, DM, DM, 0}; g.fake = (FAKE_DRY && dry) ? FAKE_DRY : 0; pg8::StaticOrder SO; SO.init(MTOK, FF2, gridDim.x, blockIdx.x, 8);
            pg8::EpiUp E{WSP(bf16_t, WS_G), WSP(float, WS_UH), WSP(float, WS_RSTD), ap->in[11] + (size_t)l * 3 * FF2, ap->in[12] + (size_t)l * FF2}; E.skip = (NULL_EPI && dry) ? 1 : 0;
            pg8::gemm_phase<pg8::EpiUp, true>(lds, g, SO, E);
            REPBAR(8);
        }
        SEAM();
        if (SITE(9) && in_ph(ph)) {
            KArgs ap = kargs(); const int tid = otid(), G = gridDim.x, bx = blockIdx.x;
            const float* cw = ap->in[11] + (size_t)l * 3 * FF2; const float* cb = ap->in[12] + (size_t)l * FF2; const float* UH = WSP(float, WS_UH); bf16_t* GB = WSP(bf16_t, WS_G);
            for (int i = bx * NTHREADS + tid; i < 128 * (FF / 4); i += G * NTHREADS) {
                const int blk = i / (FF / 4), ch = (i % (FF / 4)) * 4;
                if ((blk & 15) == 0) continue;
                const float* pc = UH + ((size_t)(blk * 4) * 2) * FF + ch; const float* pp = UH + ((size_t)((blk - 1) * 4 + 2) * 2) * FF + ch;
                const f32x4 g_2 = *(const f32x4*)pp, v_2 = *(const f32x4*)(pp + FF), g_1 = *(const f32x4*)(pp + 2 * FF), v_1 = *(const f32x4*)(pp + 3 * FF);
                const f32x4 g0 = *(const f32x4*)pc, v0 = *(const f32x4*)(pc + FF), g1 = *(const f32x4*)(pc + 2 * FF), v1 = *(const f32x4*)(pc + 3 * FF);
                const f32x4 w0g = *(const f32x4*)(cw + ch), w1g = *(const f32x4*)(cw + FF2 + ch), w2g = *(const f32x4*)(cw + 2 * FF2 + ch), bg = *(const f32x4*)(cb + ch);
                const f32x4 w0v = *(const f32x4*)(cw + FF + ch), w1v = *(const f32x4*)(cw + FF2 + FF + ch), w2v = *(const f32x4*)(cw + 2 * FF2 + FF + ch), bv = *(const f32x4*)(cb + FF + ch);
                const f32x4 yg0 = bg + w0g * g0 + w1g * g_1 + w2g * g_2, yv0 = bv + w0v * v0 + w1v * v_1 + w2v * v_2;
                const f32x4 yg1 = bg + w0g * g1 + w1g * g0 + w2g * g_1, yv1 = bv + w0v * v1 + w1v * v0 + w2v * v_1;
                f32x4 o0, o1;
#pragma unroll
                for (int jj = 0; jj < 4; ++jj) { o0[jj] = silu_f(yg0[jj]) * yv0[jj]; o1[jj] = silu_f(yg1[jj]) * yv1[jj]; }
                unsigned* d0 = (unsigned*)(GB + (size_t)(blk * 128) * FF + ch); unsigned* d1 = (unsigned*)(GB + (size_t)(blk * 128 + 1) * FF + ch);
                d0[0] = cvt_pk_bf16(o0[0], o0[1]); d0[1] = cvt_pk_bf16(o0[2], o0[3]); d1[0] = cvt_pk_bf16(o1[0], o1[1]); d1[1] = cvt_pk_bf16(o1[2], o1[3]);
            }
        }
        SEAM();
        if (SITE(10) && in_ph(ph)) REPLOOP(10) {
            KArgs ap = kargs(); const bool dry = rep + 1 < NREP(10);
            pg8::Gemm g{WSP(bf16_t, WS_G), WSP(bf16_t, WS_WDN) + (size_t)l * DM * FF, MTOK, DM, FF, FF, 0}; g.fake = (FAKE_DRY && dry) ? FAKE_DRY : 0; pg8::StaticOrder SO; SO.init(MTOK, DM, gridDim.x, blockIdx.x, WGM_DOWN);
            pg8::EpiRes E{WSP(bf16_t, WS_HB), dry ? WSP(bf16_t, WS_DUM_HB) : WSP(bf16_t, WS_HB), dry ? WSP(float, WS_DUM_SLOTS) : WSP(float, WS_SLOTS)}; E.skip = (NULL_EPI && dry) ? 1 : 0; { int sk = E.skip; asm volatile("" : "+s"(sk)); E.skip = sk; }
            if (MF32_DRY && dry) pg8::gemm_phase<pg8::EpiRes, false, true>(lds, g, SO, E); else
            pg8::gemm_phase<pg8::EpiRes, false>(lds, g, SO, E);
            REPBAR(10);
        }
        SEAM();
        if (l == 1 || l == 2) FINALIZE();
    }
    if (SITE(11) && in_ph(ph)) {
        KArgs ap = kargs(); const int tid = otid(), lane = tid & 63, wave = __builtin_amdgcn_readfirstlane(tid >> 6), G = gridDim.x, bx = blockIdx.x, gw = bx * NWAVES + wave, NGW = G * NWAVES;
        const float* SLOTS = WSP(float, WS_SLOTS); float* outp = ap->out; const float* final_norm = ap->in[14]; const bf16_t* HB = WSP(bf16_t, WS_HB);
        for (int m = gw; m < MTOK; m += NGW) {
            const float rstd = 1.0f / sqrtf(wave_sum(SLOTS[(size_t)m * 64 + lane]) * (1.0f / DM) + EPS);
            const u32x4* hr = (const u32x4*)(HB + (size_t)m * DM) + lane; float* orow = outp + (size_t)m * DM + lane * 8; const float* gr = final_norm + lane * 8;
            u32x4 hv[8];
#pragma unroll
            for (int jj = 0; jj < 8; ++jj) hv[jj] = hr[64 * jj];
#pragma unroll
            for (int jj = 0; jj < 8; ++jj) { const f32x4 g0 = *(const f32x4*)(gr + 512 * jj), g1 = *(const f32x4*)(gr + 512 * jj + 4);
                f32x4 a, b; a[0] = __uint_as_float(hv[jj].x << 16); a[1] = __uint_as_float(hv[jj].x & 0xffff0000u); a[2] = __uint_as_float(hv[jj].y << 16); a[3] = __uint_as_float(hv[jj].y & 0xffff0000u);
                b[0] = __uint_as_float(hv[jj].z << 16); b[1] = __uint_as_float(hv[jj].z & 0xffff0000u); b[2] = __uint_as_float(hv[jj].w << 16); b[3] = __uint_as_float(hv[jj].w & 0xffff0000u);
                *(f32x4*)(orow + 512 * jj) = a * rstd * g0; *(f32x4*)(orow + 512 * jj + 4) = b * rstd * g1; }
        }
    }
#undef SEAM
#undef FINALIZE
#undef WSP
}

constexpr int N_PHASES = 32;
#ifndef MK_PER_PHASE
#define MK_PER_PHASE 0
#endif

extern "C" void kernel_launch(void* const* d_in, const int* in_sizes, int n_in, void* d_out, int out_size, void* d_ws, size_t ws_size, hipStream_t stream) {
    static int grid = 0;
    if (grid == 0) {
        if (n_in != 15 || out_size != MTOK * DM || ws_size < WS_END) { fprintf(stderr, "kernel_launch: unexpected shapes (n_in %d out %d ws %zu need %zu)\n", n_in, out_size, ws_size, (size_t)WS_END); grid = -1; return; }
        int dev = 0, cus = 0, per_cu = 0;
        if (hipGetDevice(&dev) != hipSuccess || hipDeviceGetAttribute(&cus, hipDeviceAttributeMultiprocessorCount, dev) != hipSuccess) { grid = -1; return; }
        if (hipFuncSetAttribute((const void*)fwd, hipFuncAttributeMaxDynamicSharedMemorySize, LDS_BYTES) != hipSuccess) { fprintf(stderr, "kernel_launch: hipFuncSetAttribute failed\n"); grid = -1; return; }
        if (hipOccupancyMaxActiveBlocksPerMultiprocessor(&per_cu, (const void*)fwd, NTHREADS, LDS_BYTES) != hipSuccess || per_cu < 1) fprintf(stderr, "kernel_launch: occupancy query says %d\n", per_cu);
        (void)hipGetLastError();
        grid = cus;
    }
    if (grid < 0) return;
    (void)hipMemsetAsync((char*)d_ws + WS_CTL, 0, XCD_BAR_WORDS * sizeof(unsigned), stream);
    Args a{};
    for (int i = 0; i < 15; ++i) a.in[i] = (const float*)d_in[i];
    a.out = (float*)d_out; a.ws = (unsigned char*)d_ws; a.pad = 0;
#if MK_PER_PHASE
    for (int p = 0; p < N_PHASES; ++p) { a.ph_lo = p; a.ph_hi = p + 1; a.one = 0; hipLaunchKernelGGL(fwd, dim3(grid), dim3(NTHREADS), LDS_BYTES, stream, a); }
#else
    a.ph_lo = 0; a.ph_hi = N_PHASES; a.one = 1;
    hipLaunchKernelGGL(fwd, dim3(grid), dim3(NTHREADS), LDS_BYTES, stream, a);
#endif
}
```
